# Optimizing an MI355X kernel written in HIP

```python
import jax, jax.numpy as jnp
from jax import lax
import numpy as np


D_MODEL = 4096
BATCH = 1
SEQ = 16384
DEPTH = 1
DEC_BATCH = 8
DEC_SEQ = 2048
PAST_LEN = 128

HEAD_DIM = 128
A_HEADS = 16
A_WIDTH = A_HEADS * HEAD_DIM
CHUNK = 128
B_HEADS = 16
B_WIDTH = B_HEADS * HEAD_DIM
DILATION_PATTERNS = ((128, 1), (512, 4), (2048, 16))
MIX_WIDTH = A_WIDTH + B_WIDTH
IN_WIDTH = 2 * A_WIDTH + 3 * B_WIDTH
N_MEM = 256
X_HEADS = 4
X_WIDTH = X_HEADS * HEAD_DIM
D_FF = 11008
CONV_WIDTH = 3
EPS = 1e-6
NEG = -1e30

kernel_name = 'hybrid_sgmlp_dilated_attn_encoder'


def rmsnorm(x, g):
    xf = x.astype(jnp.float32)
    y = xf * lax.rsqrt(jnp.mean(xf * xf, axis=-1, keepdims=True) + EPS)
    return (y * g.astype(jnp.float32)).astype(x.dtype)


def layernorm(x, g, b):
    xf = x.astype(jnp.float32)
    mu = jnp.mean(xf, axis=-1, keepdims=True)
    var = jnp.mean(jnp.square(xf - mu), axis=-1, keepdims=True)
    y = (xf - mu) * lax.rsqrt(var + EPS)
    return (y * g.astype(jnp.float32) + b.astype(jnp.float32)).astype(x.dtype)


def alibi_slopes(n_heads):
    return jnp.exp2(-8.0 * jnp.arange(1, n_heads + 1, dtype=jnp.float32) / n_heads)


def spatial_gating(z, ln_g, ln_b, w_s, b_s):
    u, v = jnp.split(z, 2, axis=-1)
    v = layernorm(v, ln_g, ln_b)
    B, S, _ = v.shape
    v = v.reshape(B, S // CHUNK, CHUNK, A_HEADS, HEAD_DIM)
    mixed = jnp.einsum('gts,bcsge->bctge', w_s, v) + b_s.T[None, None, :, :, None]
    return u * mixed.reshape(B, S, A_WIDTH)


def dilated_window_attention(q, k, v, slopes, window, dilation):
    B, S, H, E = q.shape
    half = (window // 2) // dilation
    blk = half
    unit = dilation * blk
    Sp = -(-S // unit) * unit
    nb = Sp // unit
    pad = ((0, 0), (0, Sp - S), (0, 0), (0, 0))

    def to_blocks(a):
        return jnp.pad(a, pad).reshape(B, nb, blk, dilation, H, E)

    def with_neighbours(a):
        ap = jnp.pad(a, ((0, 0), (1, 1)) + ((0, 0),) * (a.ndim - 2))
        return jnp.concatenate([ap[:, :-2], ap[:, 1:-1], ap[:, 2:]], axis=2)

    qb = to_blocks(q).astype(jnp.float32)
    kb = with_neighbours(to_blocks(k)).astype(jnp.float32)
    vb = with_neighbours(to_blocks(v)).astype(jnp.float32)
    valid = (jnp.arange(Sp) < S).reshape(1, nb, blk, dilation)
    kvalid = with_neighbours(valid)

    s = jnp.einsum('bnirhe,bnjrhe->bnrhij', qb, kb) * (HEAD_DIM ** -0.5)
    dist = jnp.abs(jnp.arange(3 * blk)[None, :] - blk - jnp.arange(blk)[:, None])
    bias = -slopes[:, None, None] * (dist * dilation).astype(jnp.float32)
    mask = (dist <= half)[None, None, None, None] & kvalid.transpose(0, 1, 3, 2)[:, :, :, None, None, :]
    s = jnp.where(mask, s + bias, NEG)
    m = jnp.max(s, axis=-1, keepdims=True)
    p = jnp.exp(s - m)
    den = jnp.sum(p, axis=-1, keepdims=True)
    o = jnp.einsum('bnrhij,bnjrhe->bnirhe', p / den, vb)
    lse = (m + jnp.log(den))[..., 0]
    o = o.reshape(B, Sp, H, E)[:, :S]
    lse = lse.transpose(0, 1, 4, 2, 3).reshape(B, Sp, H)[:, :S]
    return o, lse


def dilated_attention_mixture(q, k, v):
    slopes = alibi_slopes(B_HEADS)
    outs, lses = [], []
    for window, dilation in DILATION_PATTERNS:
        o, lse = dilated_window_attention(q, k, v, slopes, window, dilation)
        outs.append(o)
        lses.append(lse)
    w = jax.nn.softmax(jnp.stack(lses, axis=0), axis=0)
    o = jnp.einsum('pbsh,pbshe->bshe', w, jnp.stack(outs, axis=0))
    return o.astype(q.dtype)


def memory_cross_attention(h, mem, mem_g, w_xq, w_xkv, w_xo):
    B, S, _ = h.shape
    q = (h @ w_xq).reshape(B, S, X_HEADS, HEAD_DIM)
    kv = (rmsnorm(mem, mem_g) @ w_xkv).reshape(B, mem.shape[1], 2, X_HEADS, HEAD_DIM)
    k, v = kv[:, :, 0], kv[:, :, 1]
    s = jnp.einsum('bshe,bnhe->bhsn', q.astype(jnp.float32), k.astype(jnp.float32)) * (HEAD_DIM ** -0.5)
    p = jax.nn.softmax(s, axis=-1)
    o = jnp.einsum('bhsn,bnhe->bshe', p, v.astype(jnp.float32)).astype(h.dtype)
    return o.reshape(B, S, X_WIDTH) @ w_xo


def conv_gated_ffn(h, w_up, conv_w, conv_b, w_down):
    S = h.shape[1]
    z = h @ w_up
    r = CONV_WIDTH // 2
    zp = jnp.pad(z, ((0, 0), (r, r), (0, 0)))
    z = sum(zp[:, i:i + S] * conv_w[i] for i in range(CONV_WIDTH)) + conv_b
    gate, val = jnp.split(z, 2, axis=-1)
    return (jax.nn.silu(gate) * val) @ w_down


def encoder_layer(x, mem, norm_mix_g, w_in, sg_ln_g, sg_ln_b, sg_w, sg_b, grp_a_g, grp_b_g, w_out,
                  norm_x_g, mem_norm_g, w_xq, w_xkv, w_xo, norm_ffn_g, w_up, conv_w, conv_b, w_down):
    B, S, _ = x.shape
    h = rmsnorm(x, norm_mix_g)
    proj = h @ w_in
    za = proj[..., :2 * A_WIDTH]
    qkv = proj[..., 2 * A_WIDTH:].reshape(B, S, 3, B_HEADS, HEAD_DIM)
    a_out = spatial_gating(jax.nn.gelu(za), sg_ln_g, sg_ln_b, sg_w, sg_b)
    b_out = dilated_attention_mixture(qkv[:, :, 0], qkv[:, :, 1], qkv[:, :, 2]).reshape(B, S, B_WIDTH)
    mixed = jnp.concatenate([rmsnorm(a_out, grp_a_g), rmsnorm(b_out, grp_b_g)], axis=-1)
    x = x + mixed @ w_out
    x = x + memory_cross_attention(rmsnorm(x, norm_x_g), mem, mem_norm_g, w_xq, w_xkv, w_xo)
    x = x + conv_gated_ffn(rmsnorm(x, norm_ffn_g), w_up, conv_w, conv_b, w_down)
    return x


def setup_inputs(seed: int = 0) -> dict:
    key = jax.random.key(seed)
    ks = jax.random.split(key, 24)
    f32 = jnp.float32

    def nrm(k, shape, scale):
        return jax.random.normal(k, shape, f32) * scale

    def gain(k, shape):
        return 1.0 + 0.01 * jax.random.normal(k, shape, f32)

    L = DEPTH
    return {
        'x_prompt': nrm(ks[0], (BATCH, SEQ, D_MODEL), 1.0),
        'x_sample': nrm(ks[1], (DEC_BATCH, DEC_SEQ, D_MODEL), 1.0),
        'mem_prompt': nrm(ks[2], (BATCH, N_MEM, D_MODEL), 1.0),
        'mem_sample': nrm(ks[3], (DEC_BATCH, N_MEM, D_MODEL), 1.0),
        'norm_mix_g': gain(ks[4], (L, D_MODEL)),
        'w_in': nrm(ks[5], (L, D_MODEL, IN_WIDTH), D_MODEL ** -0.5),
        'sg_ln_g': gain(ks[6], (L, A_WIDTH)),
        'sg_ln_b': nrm(ks[7], (L, A_WIDTH), 0.01),
        'sg_w': nrm(ks[8], (L, A_HEADS, CHUNK, CHUNK), CHUNK ** -0.5),
        'sg_b': gain(ks[9], (L, A_HEADS, CHUNK)),
        'grp_a_g': gain(ks[10], (L, A_WIDTH)),
        'grp_b_g': gain(ks[11], (L, B_WIDTH)),
        'w_out': nrm(ks[12], (L, MIX_WIDTH, D_MODEL), MIX_WIDTH ** -0.5),
        'norm_x_g': gain(ks[13], (L, D_MODEL)),
        'mem_norm_g': gain(ks[14], (L, D_MODEL)),
        'w_xq': nrm(ks[15], (L, D_MODEL, X_WIDTH), D_MODEL ** -0.5),
        'w_xkv': nrm(ks[16], (L, D_MODEL, 2 * X_WIDTH), D_MODEL ** -0.5),
        'w_xo': nrm(ks[17], (L, X_WIDTH, D_MODEL), X_WIDTH ** -0.5),
        'norm_ffn_g': gain(ks[18], (L, D_MODEL)),
        'w_up': nrm(ks[19], (L, D_MODEL, 2 * D_FF), D_MODEL ** -0.5),
        'conv_w': nrm(ks[20], (L, CONV_WIDTH, 2 * D_FF), CONV_WIDTH ** -0.5),
        'conv_b': nrm(ks[21], (L, 2 * D_FF), 0.01),
        'w_down': nrm(ks[22], (L, D_FF, D_MODEL), D_FF ** -0.5),
        'final_g': gain(ks[23], (D_MODEL,)),
    }


def reference(x_prompt, x_sample, mem_prompt, mem_sample, norm_mix_g, w_in, sg_ln_g, sg_ln_b, sg_w, sg_b,
              grp_a_g, grp_b_g, w_out, norm_x_g, mem_norm_g, w_xq, w_xkv, w_xo, norm_ffn_g, w_up,
              conv_w, conv_b, w_down, final_g):
    layer_params = (norm_mix_g, w_in, sg_ln_g, sg_ln_b, sg_w, sg_b, grp_a_g, grp_b_g, w_out,
                    norm_x_g, mem_norm_g, w_xq, w_xkv, w_xo, norm_ffn_g, w_up, conv_w, conv_b, w_down)

    def run(x, mem):
        for l in range(DEPTH):
            x = encoder_layer(x, mem, *[p[l] for p in layer_params])
        return rmsnorm(x, final_g)

    y_prompt = run(x_prompt, mem_prompt)
    y_sample = run(x_sample, mem_sample)
    return (y_prompt, y_sample)
```

```cpp
#include <hip/hip_runtime.h>
#include <cstdio>
#include <cstdint>
namespace pg8 {
#define PG8_LAS __attribute__((address_space(3)))
typedef unsigned short bf16_t;
typedef short bf16x8 __attribute__((ext_vector_type(8)));
typedef float f32x4 __attribute__((ext_vector_type(4)));
typedef unsigned u32x4 __attribute__((ext_vector_type(4)));
constexpr int BM = 256, BK = 64, HALF = 128, HTB = HALF * BK * 2  , STAGE_BYTES = 8 * HTB, NXCD = 8, WGM = 8;

__host__ __device__ __forceinline__ int lds_byte(int r, int c) { const int st = (r >> 4) * 2 + (c >> 5), rr = r & 15, cc = c & 31, ob = rr * 64 + cc * 2; return st * 1024 + (ob ^ (((ob >> 9) & 1) << 5)); }
__host__ __device__ __forceinline__ void stage_rc(int b, int& R, int& C) { const int st = b / 1024, sb = b % 1024, swz = sb ^ (((sb >> 9) & 1) << 5); R = (st >> 1) * 16 + swz / 64; C = (st & 1) * 32 + (swz % 64) / 2; }
__host__ __device__ __forceinline__ int perm32(int rho) { const int n = rho >> 4, i = rho & 15; return 8 * (i >> 2) + 4 * n + (i & 3); }

struct Unit { int pm, pn; };
struct Gemm { const bf16_t* A; const bf16_t* Bt; int M, N, K; };

struct StaticOrder {
    int nM, nN, nwg, G, c;
    __host__ __device__ void init(int M, int N, int G_, int c_) { nM = M / BM; nN = N / BM; nwg = nM * nN; G = G_; c = c_; }
    __host__ __device__ bool next(int i, Unit& u) const {
        const long L = (long)i * G + c; if (L >= nwg) return false;
        int wgid = (int)L; { const int q = nwg / NXCD, r = nwg % NXCD, xcd = wgid % NXCD, off = wgid / NXCD; wgid = (xcd < r ? xcd * (q + 1) : r * (q + 1) + (xcd - r) * q) + off; }
        const int nig = WGM * nN, gid = wgid / nig, fm = gid * WGM, gsz = (nM - fm) < WGM ? (nM - fm) : WGM;
        u.pm = fm + ((wgid % nig) % gsz); u.pn = (wgid % nig) / gsz; return true;
    }
    __device__ __forceinline__ void a_ready(const Unit&) const {}
    __device__ __forceinline__ void done(const Unit&) const {}
};

typedef float f32x2 __attribute__((ext_vector_type(2)));
typedef __bf16 bf16x2v __attribute__((ext_vector_type(2)));
__device__ __forceinline__ unsigned cvt_pk_bf16(float lo, float hi) { const f32x2 v = {lo, hi}; return __builtin_bit_cast(unsigned, __builtin_convertvector(v, bf16x2v)); }
__device__ __forceinline__ float gelu_tanh(float x) {
    const float t = x * (1.0f + 0.044715f * x * x) * (-2.3022082f);
    return x * __builtin_amdgcn_rcpf(1.0f + __builtin_amdgcn_exp2f(t));
}
struct EpiInProj {
    static constexpr bool PERM = true, AFTER_DRAIN = false;
    bf16_t* O; int ldc; float qscale;
    __device__ __forceinline__ void operator()(const f32x4 (&acc)[2][2][4][2], const Unit& u, int wr, int wc, int fr, int fq) const {
        const int row0 = u.pm * BM + wr * 64 + fr, col0 = u.pn * BM + wc * 32 + 8 * fq;
        const bool do_gelu = u.pn < 16; const float sc = (u.pn >= 16 && u.pn < 24) ? qscale : 1.0f;
#pragma unroll
        for (int ai = 0; ai < 2; ++ai)
#pragma unroll
            for (int m = 0; m < 4; ++m) { bf16_t* rowp = O + (size_t)(row0 + ai * HALF + m * 16) * ldc + col0;
#pragma unroll
                for (int bj = 0; bj < 2; ++bj) { f32x4 v0 = acc[ai][bj][m][0], v1 = acc[ai][bj][m][1];
                    if (do_gelu) {
#pragma unroll
                        for (int j = 0; j < 4; ++j) { v0[j] = gelu_tanh(v0[j]); v1[j] = gelu_tanh(v1[j]); } }
                    else { v0 = v0 * sc; v1 = v1 * sc; }
                    u32x4 w; w.x = cvt_pk_bf16(v0[0], v0[1]); w.y = cvt_pk_bf16(v0[2], v0[3]); w.z = cvt_pk_bf16(v1[0], v1[1]); w.w = cvt_pk_bf16(v1[2], v1[3]);
                    *(u32x4*)(rowp + bj * HALF) = w; } }
    }
};
struct EpiBf16S {
    static constexpr bool PERM = true, AFTER_DRAIN = false;
    bf16_t* O; int ldc; float scale;
    __device__ __forceinline__ void operator()(const f32x4 (&acc)[2][2][4][2], const Unit& u, int wr, int wc, int fr, int fq) const {
        const int row0 = u.pm * BM + wr * 64 + fr, col0 = u.pn * BM + wc * 32 + 8 * fq;
#pragma unroll
        for (int ai = 0; ai < 2; ++ai)
#pragma unroll
            for (int m = 0; m < 4; ++m) { bf16_t* rowp = O + (size_t)(row0 + ai * HALF + m * 16) * ldc + col0;
#pragma unroll
                for (int bj = 0; bj < 2; ++bj) { const f32x4 v0 = acc[ai][bj][m][0] * scale, v1 = acc[ai][bj][m][1] * scale;
                    u32x4 w; w.x = cvt_pk_bf16(v0[0], v0[1]); w.y = cvt_pk_bf16(v0[2], v0[3]); w.z = cvt_pk_bf16(v1[0], v1[1]); w.w = cvt_pk_bf16(v1[2], v1[3]);
                    *(u32x4*)(rowp + bj * HALF) = w; } }
    }
};
struct EpiResF32 {
    static constexpr bool PERM = false, AFTER_DRAIN = false;
    const float* base0; const float* base1; int split_pm; float* out; int ldc;
    __device__ __forceinline__ void operator()(const f32x4 (&acc)[2][2][4][2], const Unit& u, int wr, int wc, int fr, int fq) const {
        const int rowl = wr * 64 + fr, col0 = u.pn * BM + wc * 32 + 4 * fq;
        const float* bp = (u.pm < split_pm) ? base0 + (size_t)u.pm * BM * ldc : base1 + (size_t)(u.pm - split_pm) * BM * ldc;
        float* op = out + (size_t)u.pm * BM * ldc;
#pragma unroll
        for (int ai = 0; ai < 2; ++ai)
#pragma unroll
            for (int m = 0; m < 4; ++m) { const size_t off = (size_t)(rowl + ai * HALF + m * 16) * ldc + col0;
#pragma unroll
                for (int bj = 0; bj < 2; ++bj)
#pragma unroll
                    for (int n = 0; n < 2; ++n) { const f32x4 b = *(const f32x4*)(bp + off + bj * HALF + n * 16); *(f32x4*)(op + off + bj * HALF + n * 16) = b + acc[ai][bj][m][n]; } }
    }
};

template <class Epi, class Sched, bool ALIGN_EPI = false, bool SP2 = false>
__device__ __forceinline__ void gemm_phase(PG8_LAS unsigned char* lds, const Gemm g, const Sched& S, const Epi& E) {
    const int tid = threadIdx.x, wid = __builtin_amdgcn_readfirstlane(tid >> 6), lane = tid & 63, wr = wid >> 2, wc = wid & 3, fr = lane & 15, fq = lane >> 4;
    const int K = g.K, nt = K / BK;
    unsigned voffA[2], voffB[2];
#pragma unroll
    for (int i = 0; i < 2; ++i) { int R, C; stage_rc(tid * 16 + i * 8192, R, C); const int Rb = Epi::PERM ? ((R & ~31) + perm32(R & 31)) : R;
        voffA[i] = (unsigned)(R * K + C) * 2u; voffB[i] = (unsigned)(Rb * K + C) * 2u; }
    const size_t kstep = (size_t)(BK * 2);
    const size_t hstep = (size_t)HALF * K * 2;
    const size_t tstep = 2 * hstep;
    const unsigned ldsw = (unsigned)wid * 1024u;
    const int aoff = lds_byte(wr * 64 + fr, fq * 8), boff = lds_byte(wc * 32 + fr, fq * 8);
#define PG8_SA(b, h) (((b) * 2 + (h)) * HTB)
#define PG8_SB(b, h) ((4 + (b) * 2 + (h)) * HTB)
#define PG8_STAGE(bufoff, gbase, voff) do { _Pragma("unroll") for (int _i = 0; _i < 2; ++_i) \
        __builtin_amdgcn_global_load_lds((const unsigned*)((const char*)(gbase) + (voff)[_i]), (PG8_LAS unsigned*)(lds + (bufoff) + ldsw + _i * 8192), 16, 0, 0); } while (0)
#define PG8_LDA(dst, b, h) do { _Pragma("unroll") for (int m = 0; m < 4; ++m) _Pragma("unroll") for (int k = 0; k < 2; ++k) dst[m][k] = *(const PG8_LAS bf16x8*)(lds + PG8_SA(b, h) + aoff + m * 2048 + k * 1024); } while (0)
#define PG8_LDB(dst, b, h) do { _Pragma("unroll") for (int n = 0; n < 2; ++n) _Pragma("unroll") for (int k = 0; k < 2; ++k) dst[n][k] = *(const PG8_LAS bf16x8*)(lds + PG8_SB(b, h) + boff + n * 2048 + k * 1024); } while (0)
#define PG8_MMA(ai, bj, At, Bt) do { __builtin_amdgcn_s_setprio(1); _Pragma("unroll") for (int m = 0; m < 4; ++m) _Pragma("unroll") for (int n = 0; n < 2; ++n) _Pragma("unroll") for (int k = 0; k < 2; ++k) \
        acc[ai][bj][m][n] = __builtin_amdgcn_mfma_f32_16x16x32_bf16(Bt[n][k], At[m][k], acc[ai][bj][m][n], 0, 0, 0); __builtin_amdgcn_s_setprio(0); } while (0)
#define PG8_WAIT_V(n) asm volatile("s_waitcnt vmcnt(" #n ")" ::: "memory")
#define PG8_WAIT_L(n) asm volatile("s_waitcnt lgkmcnt(" #n ")" ::: "memory")
#define PG8_BAR __builtin_amdgcn_s_barrier()
#define PG8_SCHED __builtin_amdgcn_sched_barrier(0)
    Unit cur, nxt; int ui = 0;
    if (!S.next(0, cur)) return;
    f32x4 acc[2][2][4][2];
#pragma unroll
    for (int a = 0; a < 2; ++a)
#pragma unroll
        for (int b = 0; b < 2; ++b)
#pragma unroll
            for (int m = 0; m < 4; ++m)
#pragma unroll
                for (int n = 0; n < 2; ++n) acc[a][b][m][n] = (f32x4){0.f, 0.f, 0.f, 0.f};
    bf16x8 At[4][2], B0[2][2], B1[2][2];
    const char* cA = (const char*)g.A + (size_t)cur.pm * tstep; const char* cB = (const char*)g.Bt + (size_t)cur.pn * tstep;
    S.a_ready(cur);
    if constexpr (SP2) {
        PG8_STAGE(PG8_SB(0, 0), cB, voffB); PG8_STAGE(PG8_SB(0, 1), cB + hstep, voffB); PG8_STAGE(PG8_SA(0, 0), cA, voffA); PG8_STAGE(PG8_SA(0, 1), cA + hstep, voffA);
        if (wr == 1) PG8_BAR;
        PG8_WAIT_V(2); PG8_BAR;
        PG8_STAGE(PG8_SB(1, 0), cB + kstep, voffB); PG8_STAGE(PG8_SA(1, 0), cA + kstep, voffA); PG8_STAGE(PG8_SB(1, 1), cB + hstep + kstep, voffB);
        PG8_WAIT_V(6); PG8_BAR;
    } else {
        PG8_STAGE(PG8_SB(0, 0), cB, voffB); PG8_STAGE(PG8_SA(0, 0), cA, voffA); PG8_STAGE(PG8_SB(0, 1), cB + hstep, voffB); PG8_STAGE(PG8_SA(0, 1), cA + hstep, voffA);
        if (wr == 1) PG8_BAR;
        PG8_WAIT_V(4); PG8_BAR;
        PG8_STAGE(PG8_SB(1, 0), cB + kstep, voffB); PG8_STAGE(PG8_SA(1, 0), cA + kstep, voffA); PG8_STAGE(PG8_SB(1, 1), cB + hstep + kstep, voffB);
        PG8_WAIT_V(6); PG8_BAR;
    }
    for (;;) {
        const bool has_next = S.next(ui + 1, nxt);
        const char* nA = has_next ? (const char*)g.A + (size_t)nxt.pm * tstep : cA; const char* nB = has_next ? (const char*)g.Bt + (size_t)nxt.pn * tstep : cB;
        for (int t = 0; t < nt; t += 2) {
            const bool last = (t == nt - 2);
            const char* a1 = cA + (size_t)(t + 1) * kstep;
            const char* a2 = last ? nA : cA + (size_t)(t + 2) * kstep; const char* b2 = last ? nB : cB + (size_t)(t + 2) * kstep;
            const char* a3 = a2 + kstep; const char* b3 = b2 + kstep;
            if (last && has_next) S.a_ready(nxt);
            if constexpr (SP2) {
            PG8_LDB(B0, 0, 0); PG8_LDB(B1, 0, 1); PG8_SCHED; PG8_LDA(At, 0, 0); PG8_STAGE(PG8_SA(1, 1), a1 + hstep, voffA);
            PG8_WAIT_V(8); PG8_WAIT_L(0); PG8_BAR; PG8_MMA(0, 0, At, B0); PG8_MMA(0, 1, At, B1); PG8_BAR; PG8_SCHED;
            PG8_LDA(At, 0, 1); PG8_STAGE(PG8_SB(0, 0), b2, voffB); PG8_STAGE(PG8_SB(0, 1), b2 + hstep, voffB); PG8_STAGE(PG8_SA(0, 0), a2, voffA);
            PG8_WAIT_V(8); PG8_WAIT_L(0); PG8_BAR; PG8_MMA(1, 0, At, B0); PG8_MMA(1, 1, At, B1); PG8_BAR; PG8_SCHED;
            PG8_LDB(B0, 1, 0); PG8_LDB(B1, 1, 1); PG8_SCHED; PG8_LDA(At, 1, 0); PG8_STAGE(PG8_SA(0, 1), a2 + hstep, voffA);
            PG8_WAIT_V(8); PG8_WAIT_L(0); PG8_BAR; PG8_MMA(0, 0, At, B0); PG8_MMA(0, 1, At, B1); PG8_BAR; PG8_SCHED;
            PG8_LDA(At, 1, 1); PG8_STAGE(PG8_SB(1, 0), b3, voffB); PG8_STAGE(PG8_SB(1, 1), b3 + hstep, voffB); PG8_STAGE(PG8_SA(1, 0), a3, voffA);
            PG8_WAIT_V(8); PG8_WAIT_L(0); PG8_BAR; PG8_MMA(1, 0, At, B0); PG8_MMA(1, 1, At, B1); PG8_BAR; PG8_SCHED;
            } else {
            PG8_LDB(B0, 0, 0); PG8_SCHED; PG8_LDA(At, 0, 0); PG8_STAGE(PG8_SA(1, 1), a1 + hstep, voffA);
            PG8_WAIT_L(8); PG8_BAR; PG8_WAIT_L(0); PG8_MMA(0, 0, At, B0); PG8_BAR; PG8_SCHED;
            PG8_LDB(B1, 0, 1); PG8_STAGE(PG8_SB(0, 0), b2, voffB);
            PG8_BAR; PG8_WAIT_L(0); PG8_MMA(0, 1, At, B1); PG8_BAR;
            PG8_LDA(At, 0, 1); PG8_STAGE(PG8_SA(0, 0), a2, voffA);
            PG8_BAR; PG8_WAIT_L(0); PG8_MMA(1, 0, At, B0); PG8_BAR; PG8_SCHED;
            PG8_STAGE(PG8_SB(0, 1), b2 + hstep, voffB);
            PG8_WAIT_V(6); PG8_BAR; PG8_MMA(1, 1, At, B1); PG8_BAR;
            PG8_LDB(B0, 1, 0); PG8_SCHED; PG8_LDA(At, 1, 0); PG8_STAGE(PG8_SA(0, 1), a2 + hstep, voffA);
            PG8_WAIT_L(8); PG8_BAR; PG8_WAIT_L(0); PG8_MMA(0, 0, At, B0); PG8_BAR; PG8_SCHED;
            PG8_LDB(B1, 1, 1); PG8_STAGE(PG8_SB(1, 0), b3, voffB);
            PG8_BAR; PG8_WAIT_L(0); PG8_MMA(0, 1, At, B1); PG8_BAR;
            PG8_LDA(At, 1, 1); PG8_STAGE(PG8_SA(1, 0), a3, voffA);
            PG8_BAR; PG8_WAIT_L(0); PG8_MMA(1, 0, At, B0); PG8_BAR; PG8_SCHED;
            PG8_STAGE(PG8_SB(1, 1), b3 + hstep, voffB);
            PG8_WAIT_V(6); PG8_BAR; PG8_MMA(1, 1, At, B1); PG8_BAR;
            }
        }
        if constexpr (ALIGN_EPI) { if (wr == 0) PG8_BAR; }
        if constexpr (!Epi::AFTER_DRAIN) { E(acc, cur, wr, wc, fr, fq); S.done(cur); }
        if (!has_next) break;
#pragma unroll
        for (int a = 0; a < 2; ++a)
#pragma unroll
            for (int b = 0; b < 2; ++b)
#pragma unroll
                for (int m = 0; m < 4; ++m)
#pragma unroll
                    for (int n = 0; n < 2; ++n) acc[a][b][m][n] = (f32x4){0.f, 0.f, 0.f, 0.f};
        cur = nxt; cA = nA; cB = nB; ++ui;
        if constexpr (ALIGN_EPI) { if (wr == 1) PG8_BAR; }
    }
    PG8_WAIT_V(0);
    if constexpr (!ALIGN_EPI) { if (wr == 0) PG8_BAR; }
    PG8_BAR;
    if constexpr (Epi::AFTER_DRAIN) { E.fused(acc, cur, wr, wc, fr, fq, lds, wid, lane); S.done(cur); }
#undef PG8_SA
#undef PG8_SB
#undef PG8_STAGE
#undef PG8_LDA
#undef PG8_LDB
#undef PG8_MMA
#undef PG8_WAIT_V
#undef PG8_WAIT_L
#undef PG8_BAR
#undef PG8_SCHED
}
}

constexpr int NWAVES = 8;
constexpr int DM = 4096, MTOK = 32768, MPROMPT = 16384, SEQ_S = 2048;
constexpr int HD = 128, NHEAD = 16, AWID = 2048, BWID = 2048, INW = 10240, NMEMROWS = 2304, XW = 512, XHEADS = 4, DFF = 11008;
constexpr int QOFF = 4096, KOFF = 6144, VOFF = 8192;
constexpr float EPS = 1e-6f;
constexpr float LOG2E = 1.4426950408889634f;
constexpr float QSCALE = 0.08838834764831845f * LOG2E;

constexpr size_t MiB = 1u << 20;
constexpr size_t WS_CTL = 0, CTL_ZERO_BYTES = 1 * MiB;
constexpr size_t WS_SGW = 1 * MiB;
constexpr size_t WS_WIN = 2 * MiB, WS_WOUT = 82 * MiB, WS_WXQ = 114 * MiB, WS_WXKV = 118 * MiB, WS_WXO = 126 * MiB, WS_WUP = 130 * MiB, WS_WDN = 302 * MiB;
constexpr size_t WS_HN = 388 * MiB;
constexpr size_t WS_PROJ = 644 * MiB;
constexpr size_t WS_MEMN = 1284 * MiB;
constexpr size_t WS_KVX = 1302 * MiB;
constexpr size_t WS_END = 1307 * MiB;
constexpr size_t PJ_QX = 0, PJ_OX = 32 * MiB;
constexpr size_t PJ_Z = 0, PJ_G = 368 * MiB;
constexpr size_t OUT_OP = 0, OP_STRIDE = 128 * MiB, OUT_LSE = 384 * MiB;
constexpr int CW_BAR = 4096;

constexpr int RING_OFF = 0, RING_BYTES = 131072;
constexpr int LDSCTL_OFF = RING_BYTES, MISC_OFF = LDSCTL_OFF + 320;
constexpr int LDS_BYTES = 147456;
constexpr int IMG_PITCH = 320;

#define GAS __attribute__((address_space(1)))
#define LAS __attribute__((address_space(3)))
typedef unsigned short bf16;
typedef unsigned v4u __attribute__((ext_vector_type(4)));
typedef unsigned v2u __attribute__((ext_vector_type(2)));
typedef float f32x4 __attribute__((ext_vector_type(4)));
typedef float f32x16 __attribute__((ext_vector_type(16)));
typedef short bf16x8 __attribute__((ext_vector_type(8)));
typedef short s16x4 __attribute__((ext_vector_type(4)));
typedef GAS unsigned gu32;
#define RLX_AGENT __ATOMIC_RELAXED, __HIP_MEMORY_SCOPE_AGENT
#define LDS_WAIT() asm volatile("s_waitcnt lgkmcnt(0)" ::: "memory")
#define VM_WAIT() asm volatile("s_waitcnt vmcnt(0)" ::: "memory")
#define SBAR() __builtin_amdgcn_sched_barrier(0)
__device__ __forceinline__ unsigned pk2(float lo, float hi) { return pg8::cvt_pk_bf16(lo, hi); }
__device__ __forceinline__ float bflo(unsigned w) { return __uint_as_float(w << 16); }
__device__ __forceinline__ float bfhi(unsigned w) { return __uint_as_float(w & 0xffff0000u); }

#define XB_TMO      128
#define XB_XCNT(j)  (256  + 64 * (j))
#define XB_XSUB(j)  (1280 + 64 * (j))
#define XB_XGEN(j)  (2304 + 64 * (j))
#define XB_TOP      3328
#define XB_TOPGEN   3392
#define XCD_BAR_WORDS 3456
#define XB_SPIN_CAP (1u << 23)

__device__ __forceinline__ unsigned xb_ld(unsigned* p)              { return __hip_atomic_load(p, __ATOMIC_RELAXED, __HIP_MEMORY_SCOPE_AGENT); }
__device__ __forceinline__ unsigned xb_add(unsigned* p, unsigned v) { return __hip_atomic_fetch_add(p, v, __ATOMIC_RELAXED, __HIP_MEMORY_SCOPE_AGENT); }
__device__ __forceinline__ unsigned xb_xcc_id() { return (unsigned)__builtin_amdgcn_s_getreg((3 << 11) | 20) & 0xFu; }
#define XB_SPIN(cond, bar) do { unsigned _sp = 0; while (cond) { __builtin_amdgcn_s_sleep(1); \
    if ((++_sp & 255u) == 0u) { if (xb_ld(&(bar)[XB_TMO])) break; if (_sp > XB_SPIN_CAP) { atomicAdd(&(bar)[XB_TMO], 1u); break; } } } } while (0)

struct XcdBarrier { unsigned* bar; unsigned x; volatile LAS unsigned* st; };

__device__ __forceinline__ XcdBarrier xcd_barrier_post(unsigned* bar, volatile LAS unsigned* st) {
    XcdBarrier b; b.bar = bar; b.x = xb_xcc_id(); b.st = st;
    if (threadIdx.x == 0) (void)xb_add(&bar[XB_XCNT(b.x)], 1u);
    return b;
}
__device__ __forceinline__ void xcd_barrier_complete(unsigned* bar, unsigned x, unsigned& nloc, unsigned& nx) {
    const unsigned G = gridDim.x * gridDim.y * gridDim.z;
    unsigned sum, cnt, mine, sp = 0u;
    for (;;) {
        sum = 0u; cnt = 0u; mine = 0u;
#pragma unroll
        for (unsigned j = 0; j < 16; ++j) { const unsigned c = xb_ld(&bar[XB_XCNT(j)]); sum += c; cnt += (c > 0u) ? 1u : 0u; mine = (j == x) ? c : mine; }
        if (sum == G) break;
        __builtin_amdgcn_s_sleep(1);
        if ((++sp & 255u) == 0u) { if (xb_ld(&bar[XB_TMO])) break; if (sp > XB_SPIN_CAP) { atomicAdd(&bar[XB_TMO], 1u); break; } }
    }
    nloc = mine > 0u ? mine : 1u; nx = cnt > 0u ? cnt : 1u;
}
__device__ __forceinline__ void xcd_barrier(const XcdBarrier& b) {
    asm volatile("s_waitcnt vmcnt(0)" ::: "memory");
    __syncthreads();
    if (threadIdx.x == 0) {
        unsigned* bar = b.bar;
        __builtin_amdgcn_s_waitcnt(0);
        unsigned nloc = b.st[0], nx = b.st[1];
        if (nloc == 0u) { xcd_barrier_complete(bar, b.x, nloc, nx); b.st[0] = nloc; b.st[1] = nx; }
        const unsigned old = xb_add(&bar[XB_XSUB(b.x)], 1u);
        const unsigned gen = old / nloc;
        if (old + 1u == (gen + 1u) * nloc) {
            __builtin_amdgcn_fence(__ATOMIC_RELEASE, "agent");
            asm volatile("s_waitcnt vmcnt(0)" ::: "memory");
            const unsigned og = xb_add(&bar[XB_TOP], 1u);
            const unsigned tg = og / nx;
            if (og + 1u == (tg + 1u) * nx) xb_add(&bar[XB_TOPGEN], 1u);
            else XB_SPIN(xb_ld(&bar[XB_TOPGEN]) == tg, bar);
            __builtin_amdgcn_fence(__ATOMIC_ACQUIRE, "agent");
            xb_add(&bar[XB_XGEN(b.x)], 1u);
            asm volatile("s_waitcnt vmcnt(0)" ::: "memory");
        } else {
            XB_SPIN(xb_ld(&bar[XB_XGEN(b.x)]) == gen, bar);
            __builtin_amdgcn_fence(__ATOMIC_ACQUIRE, "agent");
            asm volatile("s_waitcnt vmcnt(0)" ::: "memory");
        }
    }
    __syncthreads();
}

__device__ __forceinline__ float wave_sum(float v) {
#pragma unroll
    for (int o = 1; o < 64; o <<= 1) v += __shfl_xor(v, o);
    return v;
}
__device__ __forceinline__ float half_swap_sum(float v) { const auto rr = __builtin_amdgcn_permlane32_swap(__float_as_uint(v), __float_as_uint(v), false, false); return __uint_as_float(rr[0]) + __uint_as_float(rr[1]); }
__device__ __forceinline__ float half_swap_max(float v) { const auto rr = __builtin_amdgcn_permlane32_swap(__float_as_uint(v), __float_as_uint(v), false, false); return fmaxf(__uint_as_float(rr[0]), __uint_as_float(rr[1])); }
__device__ __forceinline__ int crow(int r, int hi) { return (r & 3) + 8 * (r >> 2) + 4 * hi; }
__device__ __forceinline__ s16x4 tr_read(unsigned addr) { s16x4 r; asm volatile("ds_read_b64_tr_b16 %0, %1" : "=&v"(r) : "v"(addr) : "memory"); return r; }
#define PK8(L, H) (bf16x8){L[0], L[1], L[2], L[3], H[0], H[1], H[2], H[3]}

__device__ __forceinline__ void p0_transpose_item(const float* W, int K, int N, bf16* WT, LAS float* scr, int item, int lane) {
    const int nblk = N / 32, kb = item / nblk, nb = item % nblk, k0 = 64 * kb, n0 = 32 * nb;
#pragma unroll 8
    for (int i = 0; i < 32; ++i) { const int kk = 2 * i + (lane >> 5); scr[kk * 33 + (lane & 31)] = W[(size_t)(k0 + kk) * N + n0 + (lane & 31)]; }
    LDS_WAIT(); asm volatile("" ::: "memory");
    const int c = lane & 7;
#pragma unroll
    for (int j = 0; j < 4; ++j) { const int n = (lane >> 3) + 8 * j; const LAS float* s = scr + (8 * c) * 33 + n;
        v4u o; o.x = pk2(s[0 * 33], s[1 * 33]); o.y = pk2(s[2 * 33], s[3 * 33]); o.z = pk2(s[4 * 33], s[5 * 33]); o.w = pk2(s[6 * 33], s[7 * 33]);
        *(GAS v4u*)(WT + (size_t)(n0 + n) * K + k0 + 8 * c) = o; }
    LDS_WAIT(); asm volatile("" ::: "memory");
}
__device__ __forceinline__ void rms_row_to_bf16(const float* xrow, const float* g, bf16* orow, int lane) {
    const GAS f32x4* xr = (const GAS f32x4*)xrow + lane; const GAS f32x4* gr = (const GAS f32x4*)g + lane;
    f32x4 v[16]; float s = 0.f;
#pragma unroll
    for (int j = 0; j < 16; ++j) { v[j] = xr[64 * j]; s += (v[j].x * v[j].x + v[j].y * v[j].y) + (v[j].z * v[j].z + v[j].w * v[j].w); }
    const float rstd = 1.0f / sqrtf(wave_sum(s) * (1.f / DM) + EPS);
    GAS v2u* o8 = (GAS v2u*)orow + lane;
#pragma unroll
    for (int j = 0; j < 16; ++j) { const f32x4 gg = gr[64 * j]; v2u w; w.x = pk2(v[j].x * rstd * gg.x, v[j].y * rstd * gg.y); w.y = pk2(v[j].z * rstd * gg.z, v[j].w * rstd * gg.w); o8[64 * j] = w; }
}
__device__ __forceinline__ void rms_row_inplace(float* xrow, const float* g, int lane) {
    GAS f32x4* xr = (GAS f32x4*)xrow + lane; const GAS f32x4* gr = (const GAS f32x4*)g + lane;
    f32x4 v[16]; float s = 0.f;
#pragma unroll
    for (int j = 0; j < 16; ++j) { v[j] = xr[64 * j]; s += (v[j].x * v[j].x + v[j].y * v[j].y) + (v[j].z * v[j].z + v[j].w * v[j].w); }
    const float rstd = 1.0f / sqrtf(wave_sum(s) * (1.f / DM) + EPS);
#pragma unroll
    for (int j = 0; j < 16; ++j) { const f32x4 gg = gr[64 * j]; xr[64 * j] = v[j] * rstd * gg; }
}

template <bool DIL>
__device__ __forceinline__ void attn_tile(f32x16 (&o)[4], float& m, float& l, const bf16x8 (&qf)[8], const bf16* kp, const bf16* vp, size_t vstride4, LAS unsigned char* img, float slope2d, int lane, int kt) {
    const int c = lane & 31, hi = lane >> 5;
    bf16x8 kf[8]; v4u vr[8];
#pragma unroll
    for (int ks = 0; ks < 8; ++ks) kf[ks] = *(const GAS bf16x8*)(kp + 16 * ks);
#pragma unroll
    for (int i = 0; i < 8; ++i) vr[i] = *(const GAS v4u*)(vp + (size_t)i * vstride4);
    f32x16 s;
#pragma unroll
    for (int i = 0; i < 16; ++i) s[i] = 0.f;
#pragma unroll
    for (int ks = 0; ks < 8; ++ks) s = __builtin_amdgcn_mfma_f32_32x32x16_bf16(kf[ks], qf[ks], s, 0, 0, 0);
    LAS unsigned char* wp = img + (lane >> 4) * IMG_PITCH + 16 * (lane & 15);
#pragma unroll
    for (int i = 0; i < 8; ++i) *(LAS v4u*)(wp + 4 * i * IMG_PITCH) = vr[i];
    if (DIL) {
        const int dbase = 32 * kt + 4 * hi - c;
#pragma unroll
        for (int i = 0; i < 16; ++i) { const int diff = dbase + crow(i, 0); const int adi = diff < 0 ? -diff : diff;
            const float v = s[i] - slope2d * (float)adi;
            s[i] = (adi <= 64) ? v : -1e30f; }
    }
    float mx = s[0];
#pragma unroll
    for (int i = 1; i < 16; ++i) mx = fmaxf(mx, s[i]);
    mx = half_swap_max(mx);
    const float mn = fmaxf(m, mx), alpha = __builtin_amdgcn_exp2f(m - mn);
    float ps = 0.f;
#pragma unroll
    for (int i = 0; i < 16; ++i) { s[i] = __builtin_amdgcn_exp2f(s[i] - mn); ps += s[i]; }
    ps = half_swap_sum(ps);
    l = l * alpha + ps; m = mn;
#pragma unroll
    for (int d = 0; d < 4; ++d)
#pragma unroll
        for (int i = 0; i < 16; ++i) o[d][i] *= alpha;
    v4u w0, w1;
    w0.x = pk2(s[0], s[1]); w0.y = pk2(s[2], s[3]); w0.z = pk2(s[4], s[5]); w0.w = pk2(s[6], s[7]);
    w1.x = pk2(s[8], s[9]); w1.y = pk2(s[10], s[11]); w1.z = pk2(s[12], s[13]); w1.w = pk2(s[14], s[15]);
    const bf16x8 pb0 = __builtin_bit_cast(bf16x8, w0), pb1 = __builtin_bit_cast(bf16x8, w1);
    const unsigned rb = (unsigned)(uintptr_t)img + (unsigned)((4 * hi + ((lane & 15) >> 2)) * IMG_PITCH + 32 * ((lane >> 4) & 1) + 8 * (lane & 3));
    LDS_WAIT(); SBAR();
#pragma unroll
    for (int s2 = 0; s2 < 2; ++s2) {
        s16x4 a[4][2];
#pragma unroll
        for (int d = 0; d < 4; ++d)
#pragma unroll
            for (int t = 0; t < 2; ++t) a[d][t] = tr_read(rb + (unsigned)((16 * s2 + 8 * t) * IMG_PITCH + 64 * d));
        LDS_WAIT(); SBAR();
#pragma unroll
        for (int d = 0; d < 4; ++d) o[d] = __builtin_amdgcn_mfma_f32_32x32x16_bf16(PK8(a[d][0], a[d][1]), s2 ? pb1 : pb0, o[d], 0, 0, 0);
    }
}

__device__ __forceinline__ void attn_store(const f32x16 (&o)[4], float l, bf16* orow, int hi) {
    const float inv = 1.0f / l;
#pragma unroll
    for (int d = 0; d < 4; ++d)
#pragma unroll
        for (int g4 = 0; g4 < 4; ++g4) { v2u w; w.x = pk2(o[d][4 * g4] * inv, o[d][4 * g4 + 1] * inv); w.y = pk2(o[d][4 * g4 + 2] * inv, o[d][4 * g4 + 3] * inv);
            *(GAS v2u*)(orow + 32 * d + 8 * g4 + 4 * hi) = w; }
}

struct Args { const float* in[24]; float* out; unsigned char* ws; int ph_lo, ph_hi; };
enum { I_XP = 0, I_XS, I_MEMP, I_MEMS, I_NMIXG, I_WIN, I_SGLNG, I_SGLNB, I_SGW, I_SGB, I_GAG, I_GBG, I_WOUT, I_NXG, I_MEMG, I_WXQ, I_WXKV, I_WXO, I_NFFNG, I_WUP, I_CONVW, I_CONVB, I_WDN, I_FING };

__global__ void __launch_bounds__(NWAVES * 64, 2) fwd_kernel(Args args) {
    extern __shared__ __attribute__((aligned(16))) unsigned char lds_raw[];
    LAS unsigned char* lds = (LAS unsigned char*)lds_raw;
    volatile LAS unsigned* MISC = (volatile LAS unsigned*)(lds + MISC_OFF);
    const int tid = threadIdx.x, lane = tid & 63, wave = __builtin_amdgcn_readfirstlane(tid >> 6);
    const int G = gridDim.x, gw = blockIdx.x * NWAVES + wave, NGW = G * NWAVES;
    unsigned char* ws = args.ws;
    gu32* ctl = (gu32*)(ws + WS_CTL);
    bf16* SGWB = (bf16*)(ws + WS_SGW);
    bf16* Win_t = (bf16*)(ws + WS_WIN); bf16* Wout_t = (bf16*)(ws + WS_WOUT); bf16* Wxq_t = (bf16*)(ws + WS_WXQ); bf16* Wxkv_t = (bf16*)(ws + WS_WXKV);
    bf16* Wxo_t = (bf16*)(ws + WS_WXO); bf16* Wup_t = (bf16*)(ws + WS_WUP); bf16* Wdn_t = (bf16*)(ws + WS_WDN);
    bf16* HN = (bf16*)(ws + WS_HN); bf16* PROJ = (bf16*)(ws + WS_PROJ); bf16* MEMN = (bf16*)(ws + WS_MEMN); bf16* KVX = (bf16*)(ws + WS_KVX);
    bf16* QX = (bf16*)(ws + WS_PROJ + PJ_QX); bf16* OX = (bf16*)(ws + WS_PROJ + PJ_OX); bf16* ZB = (bf16*)(ws + WS_PROJ + PJ_Z); bf16* GB = (bf16*)(ws + WS_PROJ + PJ_G);
    float* OUT = args.out;
    unsigned char* outb = (unsigned char*)args.out;
    float* LSE = (float*)(outb + OUT_LSE);

    for (int u = tid; u < (LDS_BYTES - LDSCTL_OFF) / 4; u += NWAVES * 64) ((LAS unsigned*)(lds + LDSCTL_OFF))[u] = 0u;
    __syncthreads();
    XcdBarrier bar = xcd_barrier_post((unsigned*)(ctl + CW_BAR), MISC + 8);
#define GRID_BAR() xcd_barrier(bar)
    const int lo = args.ph_lo, hi_ph = args.ph_hi;
#ifdef PHMASK
#define IN(k) ((PHMASK >> (k)) & 1)
#else
#define IN(k) (lo <= (k) && (k) < hi_ph)
#endif

    if (IN(0)) {
        LAS float* scr = (LAS float*)(lds + RING_OFF + wave * 16384);
        constexpr int I_1 = (DM / 64) * (INW / 32), I_2 = (DM / 64) * (DM / 32), I_3 = (DM / 64) * (XW / 32), I_4 = (DM / 64) * (2 * XW / 32), I_5 = (XW / 64) * (DM / 32),
                      I_6 = (DM / 64) * (2 * DFF / 32), I_7 = (DFF / 64) * (DM / 32);
        constexpr int NITEMS = I_1 + I_2 + I_3 + I_4 + I_5 + I_6 + I_7;
        for (int it = gw; it < NITEMS; it += NGW) {
            int r = it;
            if (r < I_1) { p0_transpose_item(args.in[I_WIN], DM, INW, Win_t, scr, r, lane); continue; } r -= I_1;
            if (r < I_2) { p0_transpose_item(args.in[I_WOUT], DM, DM, Wout_t, scr, r, lane); continue; } r -= I_2;
            if (r < I_3) { p0_transpose_item(args.in[I_WXQ], DM, XW, Wxq_t, scr, r, lane); continue; } r -= I_3;
            if (r < I_4) { p0_transpose_item(args.in[I_WXKV], DM, 2 * XW, Wxkv_t, scr, r, lane); continue; } r -= I_4;
            if (r < I_5) { p0_transpose_item(args.in[I_WXO], XW, DM, Wxo_t, scr, r, lane); continue; } r -= I_5;
            if (r < I_6) { p0_transpose_item(args.in[I_WUP], DM, 2 * DFF, Wup_t, scr, r, lane); continue; } r -= I_6;
            p0_transpose_item(args.in[I_WDN], DFF, DM, Wdn_t, scr, r, lane);
        }
        for (int i = blockIdx.x * 512 + tid; i < NHEAD * 128 * 128 / 2; i += G * 512) { const float2 v = ((const float2*)args.in[I_SGW])[i]; ((unsigned*)SGWB)[i] = pk2(v.x, v.y); }
        for (int mrow = gw; mrow < MTOK; mrow += NGW) {
            const float* xr = mrow < MPROMPT ? args.in[I_XP] + (size_t)mrow * DM : args.in[I_XS] + (size_t)(mrow - MPROMPT) * DM;
            rms_row_to_bf16(xr, args.in[I_NMIXG], HN + (size_t)mrow * DM, lane); }
        for (int mrow = gw; mrow < NMEMROWS; mrow += NGW) {
            const float* xr = mrow < 256 ? args.in[I_MEMP] + (size_t)mrow * DM : args.in[I_MEMS] + (size_t)(mrow - 256) * DM;
            rms_row_to_bf16(xr, args.in[I_MEMG], MEMN + (size_t)mrow * DM, lane); }
        GRID_BAR();
    }

    if (IN(1)) {
        { pg8::Gemm g{HN, Win_t, MTOK, INW, DM}; pg8::StaticOrder S; S.init(MTOK, INW, G, (int)blockIdx.x);
          pg8::EpiInProj E{PROJ, INW, QSCALE};
          pg8::gemm_phase<pg8::EpiInProj, pg8::StaticOrder, true, true>(lds + RING_OFF, g, S, E); }
        { pg8::Gemm g{MEMN, Wxkv_t, NMEMROWS, 2 * XW, DM}; pg8::StaticOrder S; S.init(NMEMROWS, 2 * XW, G, (int)blockIdx.x);
          pg8::EpiBf16S E{KVX, 2 * XW, 1.0f};
          pg8::gemm_phase<pg8::EpiBf16S, pg8::StaticOrder, true, true>(lds + RING_OFF, g, S, E); }
        GRID_BAR();
    }

    if (IN(2)) {
#ifndef NO_SG
        LAS float* stat_mean = (LAS float*)(lds + 81920); LAS float* stat_rstd = stat_mean + 128; LAS float* ssqL = stat_mean + 256;
        const float* lng = args.in[I_SGLNG]; const float* lnb = args.in[I_SGLNB]; const float* sgb = args.in[I_SGB]; const float* gag = args.in[I_GAG];
        for (int ck = blockIdx.x; ck < MTOK / 128; ck += G) {
            const int R0 = ck * 128;
            for (int rr = 0; rr < 16; ++rr) { const int srow = wave * 16 + rr; const GAS v4u* vp = (const GAS v4u*)(PROJ + (size_t)(R0 + srow) * INW + AWID) + lane;
                float x[32]; float sm = 0.f;
#pragma unroll
                for (int j = 0; j < 4; ++j) { const v4u w = vp[64 * j];
                    x[8 * j + 0] = bflo(w.x); x[8 * j + 1] = bfhi(w.x); x[8 * j + 2] = bflo(w.y); x[8 * j + 3] = bfhi(w.y); x[8 * j + 4] = bflo(w.z); x[8 * j + 5] = bfhi(w.z); x[8 * j + 6] = bflo(w.w); x[8 * j + 7] = bfhi(w.w); }
#pragma unroll
                for (int j = 0; j < 32; ++j) sm += x[j];
                const float mean = wave_sum(sm) * (1.f / AWID); float sq = 0.f;
#pragma unroll
                for (int j = 0; j < 32; ++j) { const float d = x[j] - mean; sq += d * d; }
                const float rstd = 1.0f / sqrtf(wave_sum(sq) * (1.f / AWID) + EPS);
                if (lane == 0) { stat_mean[srow] = mean; stat_rstd[srow] = rstd; } }
            __syncthreads();
            const int hh = wave >> 2, tb = wave & 3, c = lane & 31, hi = lane >> 5;
            float ssq = 0.f;
            for (int hp = 0; hp < 8; ++hp) {
                { const int ch32 = tid & 31, colbase = 256 * hp + 8 * ch32;
                  float gv[8], bv[8];
#pragma unroll
                  for (int j = 0; j < 8; ++j) { gv[j] = lng[colbase + j]; bv[j] = lnb[colbase + j]; }
                  LAS unsigned char* ib = lds + (ch32 >> 4) * (128 * IMG_PITCH) + 16 * (ch32 & 15);
#pragma unroll
                  for (int i = 0; i < 8; ++i) { const int srow = (tid >> 5) + 16 * i;
                      const v4u w = *(const GAS v4u*)(PROJ + (size_t)(R0 + srow) * INW + AWID + colbase);
                      const float mu = stat_mean[srow], rs = stat_rstd[srow];
                      v4u o;
                      o.x = pk2((bflo(w.x) - mu) * rs * gv[0] + bv[0], (bfhi(w.x) - mu) * rs * gv[1] + bv[1]);
                      o.y = pk2((bflo(w.y) - mu) * rs * gv[2] + bv[2], (bfhi(w.y) - mu) * rs * gv[3] + bv[3]);
                      o.z = pk2((bflo(w.z) - mu) * rs * gv[4] + bv[4], (bfhi(w.z) - mu) * rs * gv[5] + bv[5]);
                      o.w = pk2((bflo(w.w) - mu) * rs * gv[6] + bv[6], (bfhi(w.w) - mu) * rs * gv[7] + bv[7]);
                      *(LAS v4u*)(ib + srow * IMG_PITCH) = o; } }
                __syncthreads();
                { int lz = lane; asm volatile("" : "+v"(lz)); const int c = lz & 31, hi = lz >> 5;
                  const int g = 2 * hp + hh, t = 32 * tb + c;
                  bf16x8 wf[8];
                  const bf16* wrow = SGWB + ((size_t)(g * 128 + t)) * 128 + 8 * hi;
#pragma unroll
                  for (int ks = 0; ks < 8; ++ks) wf[ks] = *(const GAS bf16x8*)(wrow + 16 * ks);
                  f32x16 acc[4];
#pragma unroll
                  for (int d = 0; d < 4; ++d)
#pragma unroll
                      for (int i = 0; i < 16; ++i) acc[d][i] = 0.f;
                  const unsigned rb = (unsigned)(uintptr_t)(lds + hh * (128 * IMG_PITCH)) + (unsigned)((8 * hi + ((lz & 15) >> 2)) * IMG_PITCH + 32 * ((lz >> 4) & 1) + 8 * (lz & 3));
#pragma unroll
                  for (int ks = 0; ks < 8; ++ks) {
                      s16x4 a[4][2];
#pragma unroll
                      for (int d = 0; d < 4; ++d)
#pragma unroll
                          for (int tt = 0; tt < 2; ++tt) a[d][tt] = tr_read(rb + (unsigned)((16 * ks + 4 * tt) * IMG_PITCH + 64 * d));
                      LDS_WAIT(); SBAR();
#pragma unroll
                      for (int d = 0; d < 4; ++d) acc[d] = __builtin_amdgcn_mfma_f32_32x32x16_bf16(PK8(a[d][0], a[d][1]), wf[ks], acc[d], 0, 0, 0);
                  }
                  const float bs = sgb[g * 128 + t];
                  const bf16* urow = PROJ + (size_t)(R0 + t) * INW + g * 128 + 4 * hi;
                  bf16* orow = HN + (size_t)(R0 + t) * DM + g * 128 + 4 * hi;
#pragma unroll
                  for (int d = 0; d < 4; ++d)
#pragma unroll
                      for (int g4 = 0; g4 < 4; ++g4) { const v2u uu = *(const GAS v2u*)(urow + 32 * d + 8 * g4);
                          const float a0 = bflo(uu.x) * (acc[d][4 * g4] + bs), a1 = bfhi(uu.x) * (acc[d][4 * g4 + 1] + bs), a2 = bflo(uu.y) * (acc[d][4 * g4 + 2] + bs), a3 = bfhi(uu.y) * (acc[d][4 * g4 + 3] + bs);
                          ssq += (a0 * a0 + a1 * a1) + (a2 * a2 + a3 * a3);
                          v2u w; w.x = pk2(a0, a1); w.y = pk2(a2, a3); *(GAS v2u*)(orow + 32 * d + 8 * g4) = w; }
                }
                __syncthreads();
            }
            ssq = half_swap_sum(ssq);
            if (hi == 0) ssqL[hh * 128 + 32 * tb + c] = ssq;
            VM_WAIT();
            __syncthreads();
            { const int cc = tid & 255;
              float gg[8];
#pragma unroll
              for (int j = 0; j < 8; ++j) gg[j] = gag[8 * cc + j];
              for (int i = 0; i < 64; ++i) { const int t = (tid >> 8) + 2 * i; const float rs = 1.0f / sqrtf((ssqL[t] + ssqL[128 + t]) * (1.f / AWID) + EPS);
                  GAS v4u* p = (GAS v4u*)(HN + (size_t)(R0 + t) * DM + 8 * cc); const v4u w = *p; v4u o;
                  o.x = pk2(bflo(w.x) * rs * gg[0], bfhi(w.x) * rs * gg[1]); o.y = pk2(bflo(w.y) * rs * gg[2], bfhi(w.y) * rs * gg[3]);
                  o.z = pk2(bflo(w.z) * rs * gg[4], bfhi(w.z) * rs * gg[5]); o.w = pk2(bflo(w.w) * rs * gg[6], bfhi(w.w) * rs * gg[7]); *p = o; } }
            __syncthreads();
        }
#endif
#ifndef NO_DIL
        { LAS unsigned char* img = lds + wave * (32 * IMG_PITCH);
          const int c = lane & 31, hi = lane >> 5;
          constexpr int NITEM = 3 * NHEAD * (MTOK / 32);
          const int ipw = (NITEM + NGW - 1) / NGW; const int it0 = gw * ipw, it1 = (it0 + ipw < NITEM) ? it0 + ipw : NITEM;
          for (int it = it0; it < it1; ++it) {
              const int p = it / (NHEAD * 1024), rem = it % (NHEAD * 1024), h = rem / 1024, tbk = rem % 1024;
              const int d = (p == 0) ? 1 : (p == 1 ? 4 : 16);
              int base, S, local;
              if (tbk < 512) { base = 0; S = MPROMPT; local = tbk; } else { base = MPROMPT + SEQ_S * ((tbk - 512) >> 6); S = SEQ_S; local = (tbk - 512) & 63; }
              const int nq = S / d, bpr = nq / 32, r = local / bpr, qb = local % bpr;
              const float slope2d = __builtin_amdgcn_exp2f(-0.5f * (float)(h + 1)) * LOG2E * (float)d;
              const size_t rowq = (size_t)(base + (32 * qb + c) * d + r);
              bf16x8 qf[8];
              { const bf16* qp = PROJ + rowq * INW + QOFF + h * HD + 8 * hi;
#pragma unroll
                for (int ks = 0; ks < 8; ++ks) qf[ks] = *(const GAS bf16x8*)(qp + 16 * ks); }
              f32x16 o[4];
#pragma unroll
              for (int dd = 0; dd < 4; ++dd)
#pragma unroll
                  for (int i = 0; i < 16; ++i) o[dd][i] = 0.f;
              float m = -1e30f, l = 0.f;
              const size_t vstride4 = (size_t)4 * d * INW;
#pragma unroll 1
              for (int j = 0; j < 5; ++j) { const int kt = (j & 1) ? -((j + 1) >> 1) : (j >> 1);
                  const int n0 = 32 * (qb + kt); if (n0 < 0 || n0 >= nq) continue;
                  const bf16* kp = PROJ + (size_t)(base + (n0 + c) * d + r) * INW + KOFF + h * HD + 8 * hi;
                  const bf16* vp = PROJ + (size_t)(base + (n0 + (lane >> 4)) * d + r) * INW + VOFF + h * HD + 8 * (lane & 15);
                  attn_tile<true>(o, m, l, qf, kp, vp, vstride4, img, slope2d, lane, kt); }
              attn_store(o, l, (bf16*)(outb + OUT_OP + (size_t)p * OP_STRIDE) + rowq * BWID + h * HD, hi);
              if (hi == 0) LSE[((size_t)p * MTOK + rowq) * NHEAD + h] = m + __builtin_amdgcn_logf(l);
          } }
#endif
        GRID_BAR();
    }

    if (IN(3)) {
        const float* gbg = args.in[I_GBG];
        for (int row = gw; row < MTOK; row += NGW) {
            const int h = lane >> 2;
            const float l0 = LSE[((size_t)0 * MTOK + row) * NHEAD + h], l1 = LSE[((size_t)1 * MTOK + row) * NHEAD + h], l2 = LSE[((size_t)2 * MTOK + row) * NHEAD + h];
            const float mx = fmaxf(l0, fmaxf(l1, l2));
            float w0 = __builtin_amdgcn_exp2f(l0 - mx), w1 = __builtin_amdgcn_exp2f(l1 - mx), w2 = __builtin_amdgcn_exp2f(l2 - mx);
            const float inv = 1.0f / (w0 + w1 + w2); w0 *= inv; w1 *= inv; w2 *= inv;
            float b[32];
#pragma unroll
            for (int j = 0; j < 32; ++j) b[j] = 0.f;
#pragma unroll
            for (int p = 0; p < 3; ++p) { const float wp = p == 0 ? w0 : (p == 1 ? w1 : w2);
                const GAS v4u* op = (const GAS v4u*)((const bf16*)(outb + OUT_OP + (size_t)p * OP_STRIDE) + (size_t)row * BWID + 32 * lane);
#pragma unroll
                for (int j = 0; j < 4; ++j) { const v4u w = op[j];
                    b[8 * j + 0] += wp * bflo(w.x); b[8 * j + 1] += wp * bfhi(w.x); b[8 * j + 2] += wp * bflo(w.y); b[8 * j + 3] += wp * bfhi(w.y);
                    b[8 * j + 4] += wp * bflo(w.z); b[8 * j + 5] += wp * bfhi(w.z); b[8 * j + 6] += wp * bflo(w.w); b[8 * j + 7] += wp * bfhi(w.w); } }
            float sq = 0.f;
#pragma unroll
            for (int j = 0; j < 32; ++j) sq += b[j] * b[j];
            const float rs = 1.0f / sqrtf(wave_sum(sq) * (1.f / BWID) + EPS);
            GAS v4u* dst = (GAS v4u*)(HN + (size_t)row * DM + AWID + 32 * lane);
            const GAS f32x4* gp = (const GAS f32x4*)(gbg + 32 * lane);
#pragma unroll
            for (int j = 0; j < 4; ++j) { const f32x4 ga = gp[2 * j], gc = gp[2 * j + 1]; v4u o;
                o.x = pk2(b[8 * j + 0] * rs * ga.x, b[8 * j + 1] * rs * ga.y); o.y = pk2(b[8 * j + 2] * rs * ga.z, b[8 * j + 3] * rs * ga.w);
                o.z = pk2(b[8 * j + 4] * rs * gc.x, b[8 * j + 5] * rs * gc.y); o.w = pk2(b[8 * j + 6] * rs * gc.z, b[8 * j + 7] * rs * gc.w); dst[j] = o; }
        }
        GRID_BAR();
    }

    if (IN(4)) {
        pg8::Gemm g{HN, Wout_t, MTOK, DM, DM}; pg8::StaticOrder S; S.init(MTOK, DM, G, (int)blockIdx.x);
        pg8::EpiResF32 E{args.in[I_XP], args.in[I_XS], MPROMPT / 256, OUT, DM};
        pg8::gemm_phase<pg8::EpiResF32, pg8::StaticOrder, true, true>(lds + RING_OFF, g, S, E);
        GRID_BAR();
    }
    if (IN(5)) {
        for (int mrow = gw; mrow < MTOK; mrow += NGW) rms_row_to_bf16(OUT + (size_t)mrow * DM, args.in[I_NXG], HN + (size_t)mrow * DM, lane);
        GRID_BAR();
    }
    if (IN(6)) {
        pg8::Gemm g{HN, Wxq_t, MTOK, XW, DM}; pg8::StaticOrder S; S.init(MTOK, XW, G, (int)blockIdx.x);
        pg8::EpiBf16S E{QX, XW, QSCALE};
        pg8::gemm_phase<pg8::EpiBf16S, pg8::StaticOrder, true, true>(lds + RING_OFF, g, S, E);
        GRID_BAR();
    }
    if (IN(7)) {
        LAS unsigned char* img = lds + wave * (32 * IMG_PITCH);
        const int c = lane & 31, hi = lane >> 5;
        constexpr int NITEM = XHEADS * (MTOK / 32);
        const int ipw = (NITEM + NGW - 1) / NGW; const int it0 = gw * ipw, it1 = (it0 + ipw < NITEM) ? it0 + ipw : NITEM;
        for (int it = it0; it < it1; ++it) {
            const int xh = it / 1024, tbk = it % 1024, R = 32 * tbk;
            const int mrow0 = (R < MPROMPT) ? 0 : 256 + 256 * ((R - MPROMPT) / SEQ_S);
            bf16x8 qf[8];
            { const bf16* qp = QX + (size_t)(R + c) * XW + xh * HD + 8 * hi;
#pragma unroll
              for (int ks = 0; ks < 8; ++ks) qf[ks] = *(const GAS bf16x8*)(qp + 16 * ks); }
            f32x16 o[4];
#pragma unroll
            for (int dd = 0; dd < 4; ++dd)
#pragma unroll
                for (int i = 0; i < 16; ++i) o[dd][i] = 0.f;
            float m = -1e30f, l = 0.f;
            for (int kt = 0; kt < 8; ++kt) {
                const bf16* kp = KVX + (size_t)(mrow0 + 32 * kt + c) * (2 * XW) + xh * HD + 8 * hi;
                const bf16* vp = KVX + (size_t)(mrow0 + 32 * kt + (lane >> 4)) * (2 * XW) + XW + xh * HD + 8 * (lane & 15);
                attn_tile<false>(o, m, l, qf, kp, vp, (size_t)4 * 2 * XW, img, 0.f, lane, 0);
            }
            attn_store(o, l, OX + (size_t)(R + c) * XW + xh * HD, hi);
        }
        GRID_BAR();
    }
    if (IN(8)) {
        pg8::Gemm g{OX, Wxo_t, MTOK, DM, XW}; pg8::StaticOrder S; S.init(MTOK, DM, G, (int)blockIdx.x);
        pg8::EpiResF32 E{OUT, OUT, 1 << 30, OUT, DM};
        pg8::gemm_phase<pg8::EpiResF32, pg8::StaticOrder, true, true>(lds + RING_OFF, g, S, E);
        GRID_BAR();
    }
    if (IN(9)) {
        for (int mrow = gw; mrow < MTOK; mrow += NGW) rms_row_to_bf16(OUT + (size_t)mrow * DM, args.in[I_NFFNG], HN + (size_t)mrow * DM, lane);
        GRID_BAR();
    }
    if (IN(10)) {
        const float* cw = args.in[I_CONVW]; const float* cb = args.in[I_CONVB];
#pragma unroll
        for (int ch = 0; ch < 4; ++ch) {
            const int p_lo = 32 * ch - (ch == 1 ? 1 : 0), np = 32 + (ch < 2 ? 1 : 0), zrow0 = p_lo * 256, r0 = 8192 * ch;
            { pg8::Gemm g{HN + (size_t)zrow0 * DM, Wup_t, np * 256, 2 * DFF, DM}; pg8::StaticOrder S; S.init(np * 256, 2 * DFF, G, (int)blockIdx.x);
              pg8::EpiBf16S E{ZB, 2 * DFF, 1.0f};
              pg8::gemm_phase<pg8::EpiBf16S, pg8::StaticOrder, true, true>(lds + RING_OFF, g, S, E); }
            GRID_BAR();
            { constexpr int NCC = DFF / 8, NRB = 8192 / 16;
              for (int item = blockIdx.x * 512 + tid; item < NCC * NRB; item += G * 512) {
                  const int cc = item % NCC, rb = item / NCC, col = 8 * cc, t0 = r0 + 16 * rb;
                  float wg[3][8], wv[3][8], bg[8], bvv[8];
#pragma unroll
                  for (int k = 0; k < 3; ++k)
#pragma unroll
                      for (int j = 0; j < 8; ++j) { wg[k][j] = cw[k * (2 * DFF) + col + j]; wv[k][j] = cw[k * (2 * DFF) + DFF + col + j]; }
#pragma unroll
                  for (int j = 0; j < 8; ++j) { bg[j] = cb[col + j]; bvv[j] = cb[DFF + col + j]; }
                  const bf16* zbase = ZB + (size_t)(t0 - zrow0) * (2 * DFF) + col;
                  v4u gp, gc, gn, vp, vc, vn;
                  const bool first_has_prev = (t0 < MPROMPT) ? (t0 != 0) : ((t0 & (SEQ_S - 1)) != 0);
                  if (first_has_prev) { gp = *(const GAS v4u*)(zbase - (size_t)(2 * DFF)); vp = *(const GAS v4u*)(zbase - (size_t)(2 * DFF) + DFF); } else { gp = (v4u){0u, 0u, 0u, 0u}; vp = gp; }
                  gc = *(const GAS v4u*)(zbase); vc = *(const GAS v4u*)(zbase + DFF);
                  for (int rr = 0; rr < 16; ++rr) { const int t = t0 + rr;
                      const bool has_next = (t < MPROMPT) ? (t != MPROMPT - 1) : ((t & (SEQ_S - 1)) != SEQ_S - 1);
                      if (has_next) { gn = *(const GAS v4u*)(zbase + (size_t)(rr + 1) * (2 * DFF)); vn = *(const GAS v4u*)(zbase + (size_t)(rr + 1) * (2 * DFF) + DFF); } else { gn = (v4u){0u, 0u, 0u, 0u}; vn = gn; }
                      float og[8];
#define CG(j, P, C, N, VP, VC, VN, SEL) { const float zg = SEL(P) * wg[0][j] + SEL(C) * wg[1][j] + SEL(N) * wg[2][j] + bg[j]; const float zv = SEL(VP) * wv[0][j] + SEL(VC) * wv[1][j] + SEL(VN) * wv[2][j] + bvv[j]; \
                          og[j] = zg * __builtin_amdgcn_rcpf(1.0f + __builtin_amdgcn_exp2f(-LOG2E * zg)) * zv; }
                      CG(0, gp.x, gc.x, gn.x, vp.x, vc.x, vn.x, bflo) CG(1, gp.x, gc.x, gn.x, vp.x, vc.x, vn.x, bfhi)
                      CG(2, gp.y, gc.y, gn.y, vp.y, vc.y, vn.y, bflo) CG(3, gp.y, gc.y, gn.y, vp.y, vc.y, vn.y, bfhi)
                      CG(4, gp.z, gc.z, gn.z, vp.z, vc.z, vn.z, bflo) CG(5, gp.z, gc.z, gn.z, vp.z, vc.z, vn.z, bfhi)
                      CG(6, gp.w, gc.w, gn.w, vp.w, vc.w, vn.w, bflo) CG(7, gp.w, gc.w, gn.w, vp.w, vc.w, vn.w, bfhi)
#undef CG
                      v4u o; o.x = pk2(og[0], og[1]); o.y = pk2(og[2], og[3]); o.z = pk2(og[4], og[5]); o.w = pk2(og[6], og[7]);
                      *(GAS v4u*)(GB + (size_t)(t - r0) * DFF + col) = o;
                      gp = gc; gc = gn; vp = vc; vc = vn; }
              } }
            GRID_BAR();
            { pg8::Gemm g{GB, Wdn_t, 8192, DM, DFF}; pg8::StaticOrder S; S.init(8192, DM, G, (int)blockIdx.x);
              float* ob = OUT + (size_t)r0 * DM;
              pg8::EpiResF32 E{ob, ob, 1 << 30, ob, DM};
              pg8::gemm_phase<pg8::EpiResF32, pg8::StaticOrder, true, true>(lds + RING_OFF, g, S, E); }
            GRID_BAR();
        }
    }
    if (IN(11)) {
        for (int mrow = gw; mrow < MTOK; mrow += NGW) rms_row_inplace(OUT + (size_t)mrow * DM, args.in[I_FING], lane);
    }
#undef IN
#undef GRID_BAR
}

extern "C" void kernel_launch(void* const* d_in, const int* in_sizes, int n_in, void* d_out, int out_size, void* d_ws, size_t ws_size, hipStream_t stream) {
    static int grid = 0;
    if (grid == 0) {
        if (n_in != 24 || out_size != MTOK * DM || ws_size < WS_END) { fprintf(stderr, "kernel_launch: unexpected shapes (n_in %d, out %d, ws %zu)\n", n_in, out_size, ws_size); grid = -1; return; }
        int dev = 0, cus = 0, per_cu = 0;
        if (hipGetDevice(&dev) != hipSuccess || hipDeviceGetAttribute(&cus, hipDeviceAttributeMultiprocessorCount, dev) != hipSuccess) { grid = -1; return; }
        if (hipFuncSetAttribute((const void*)fwd_kernel, hipFuncAttributeMaxDynamicSharedMemorySize, LDS_BYTES) != hipSuccess) { fprintf(stderr, "kernel_launch: hipFuncSetAttribute failed\n"); grid = -1; return; }
        if (hipOccupancyMaxActiveBlocksPerMultiprocessor(&per_cu, (const void*)fwd_kernel, NWAVES * 64, LDS_BYTES) != hipSuccess || per_cu < 1) { fprintf(stderr, "kernel_launch: occupancy query reports %d\n", per_cu); }
        (void)hipGetLastError();
        grid = cus;
    }
    if (grid < 0) return;
    if (hipMemsetAsync((char*)d_ws + WS_CTL, 0, CTL_ZERO_BYTES, stream) != hipSuccess) { fprintf(stderr, "kernel_launch: memset failed\n"); return; }
    Args a{};
    for (int i = 0; i < 24; ++i) a.in[i] = (const float*)d_in[i];
    a.out = (float*)d_out; a.ws = (unsigned char*)d_ws; a.ph_lo = 0; a.ph_hi = 12;
    hipLaunchKernelGGL(fwd_kernel, dim3(grid), dim3(NWAVES * 64), LDS_BYTES, stream, a);
    const hipError_t le = hipPeekAtLastError();
    if (le != hipSuccess) fprintf(stderr, "kernel_launch: launch failed: %s\n", hipGetErrorName(le));
}
```

```cpp
#include <hip/hip_runtime.h>
#include <cstdio>
#include <cstdint>
namespace pg8 {
#define PG8_LAS __attribute__((address_space(3)))
typedef unsigned short bf16_t;
typedef short bf16x8 __attribute__((ext_vector_type(8)));
typedef float f32x4 __attribute__((ext_vector_type(4)));
typedef unsigned u32x4 __attribute__((ext_vector_type(4)));
constexpr int BM = 256, BK = 64, HALF = 128, HTB = HALF * BK * 2  , STAGE_BYTES = 8 * HTB, NXCD = 8, WGM = 8;

__host__ __device__ __forceinline__ int lds_byte(int r, int c) { const int st = (r >> 4) * 2 + (c >> 5), rr = r & 15, cc = c & 31, ob = rr * 64 + cc * 2; return st * 1024 + (ob ^ (((ob >> 9) & 1) << 5)); }
__host__ __device__ __forceinline__ void stage_rc(int b, int& R, int& C) { const int st = b / 1024, sb = b % 1024, swz = sb ^ (((sb >> 9) & 1) << 5); R = (st >> 1) * 16 + swz / 64; C = (st & 1) * 32 + (swz % 64) / 2; }
__host__ __device__ __forceinline__ int perm32(int rho) { const int n = rho >> 4, i = rho & 15; return 8 * (i >> 2) + 4 * n + (i & 3); }

struct Unit { int pm, pn; };
struct Gemm { const bf16_t* A; const bf16_t* Bt; int M, N, K; };

struct StaticOrder {
    int nM, nN, nwg, G, c;
    __host__ __device__ void init(int M, int N, int G_, int c_) { nM = M / BM; nN = N / BM; nwg = nM * nN; G = G_; c = c_; }
    __host__ __device__ bool next(int i, Unit& u) const {
        const long L = (long)i * G + c; if (L >= nwg) return false;
        int wgid = (int)L; { const int q = nwg / NXCD, r = nwg % NXCD, xcd = wgid % NXCD, off = wgid / NXCD; wgid = (xcd < r ? xcd * (q + 1) : r * (q + 1) + (xcd - r) * q) + off; }
        const int nig = WGM * nN, gid = wgid / nig, fm = gid * WGM, gsz = (nM - fm) < WGM ? (nM - fm) : WGM;
        u.pm = fm + ((wgid % nig) % gsz); u.pn = (wgid % nig) / gsz; return true;
    }
    __device__ __forceinline__ void a_ready(const Unit&) const {}
    __device__ __forceinline__ void done(const Unit&) const {}
};

typedef float f32x2 __attribute__((ext_vector_type(2)));
typedef __bf16 bf16x2v __attribute__((ext_vector_type(2)));
__device__ __forceinline__ unsigned cvt_pk_bf16(float lo, float hi) { const f32x2 v = {lo, hi}; return __builtin_bit_cast(unsigned, __builtin_convertvector(v, bf16x2v)); }
__device__ __forceinline__ float gelu_tanh(float x) {
    const float t = x * (1.0f + 0.044715f * x * x) * (-2.3022082f);
    return x * __builtin_amdgcn_rcpf(1.0f + __builtin_amdgcn_exp2f(t));
}
struct EpiInProj {
    static constexpr bool PERM = true, AFTER_DRAIN = false;
    bf16_t* O; int ldc; float qscale;
    __device__ __forceinline__ void operator()(const f32x4 (&acc)[2][2][4][2], const Unit& u, int wr, int wc, int fr, int fq) const {
        const int row0 = u.pm * BM + wr * 64 + fr, col0 = u.pn * BM + wc * 32 + 8 * fq;
        const bool do_gelu = u.pn < 16; const float sc = (u.pn >= 16 && u.pn < 24) ? qscale : 1.0f;
#pragma unroll
        for (int ai = 0; ai < 2; ++ai)
#pragma unroll
            for (int m = 0; m < 4; ++m) { bf16_t* rowp = O + (size_t)(row0 + ai * HALF + m * 16) * ldc + col0;
#pragma unroll
                for (int bj = 0; bj < 2; ++bj) { f32x4 v0 = acc[ai][bj][m][0], v1 = acc[ai][bj][m][1];
                    if (do_gelu) {
#pragma unroll
                        for (int j = 0; j < 4; ++j) { v0[j] = gelu_tanh(v0[j]); v1[j] = gelu_tanh(v1[j]); } }
                    else { v0 = v0 * sc; v1 = v1 * sc; }
                    u32x4 w; w.x = cvt_pk_bf16(v0[0], v0[1]); w.y = cvt_pk_bf16(v0[2], v0[3]); w.z = cvt_pk_bf16(v1[0], v1[1]); w.w = cvt_pk_bf16(v1[2], v1[3]);
                    *(u32x4*)(rowp + bj * HALF) = w; } }
    }
};
struct EpiBf16S {
    static constexpr bool PERM = true, AFTER_DRAIN = false;
    bf16_t* O; int ldc; float scale0; const float* ssq;
    __device__ __forceinline__ void operator()(const f32x4 (&acc)[2][2][4][2], const Unit& u, int wr, int wc, int fr, int fq) const {
        const int row0 = u.pm * BM + wr * 64 + fr, col0 = u.pn * BM + wc * 32 + 8 * fq;
#pragma unroll
        for (int ai = 0; ai < 2; ++ai)
#pragma unroll
            for (int m = 0; m < 4; ++m) { bf16_t* rowp = O + (size_t)(row0 + ai * HALF + m * 16) * ldc + col0;
                const float scale = ssq ? scale0 * __builtin_amdgcn_rsqf(ssq[row0 + ai * HALF + m * 16] * (1.0f / 4096.0f) + 1e-6f) : scale0;
#pragma unroll
                for (int bj = 0; bj < 2; ++bj) { const f32x4 v0 = acc[ai][bj][m][0] * scale, v1 = acc[ai][bj][m][1] * scale;
                    u32x4 w; w.x = cvt_pk_bf16(v0[0], v0[1]); w.y = cvt_pk_bf16(v0[2], v0[3]); w.z = cvt_pk_bf16(v1[0], v1[1]); w.w = cvt_pk_bf16(v1[2], v1[3]);
                    *(u32x4*)(rowp + bj * HALF) = w; } }
    }
};
struct EpiResF32 {
    static constexpr bool PERM = false, AFTER_DRAIN = false;
    const float* base0; const float* base1; int split_pm; float* out; int ldc;
    __device__ __forceinline__ void operator()(const f32x4 (&acc)[2][2][4][2], const Unit& u, int wr, int wc, int fr, int fq) const {
        const int rowl = wr * 64 + fr, col0 = u.pn * BM + wc * 32 + 4 * fq;
        const float* bp = (u.pm < split_pm) ? base0 + (size_t)u.pm * BM * ldc : base1 + (size_t)(u.pm - split_pm) * BM * ldc;
        float* op = out + (size_t)u.pm * BM * ldc;
#pragma unroll
        for (int ai = 0; ai < 2; ++ai)
#pragma unroll
            for (int m = 0; m < 4; ++m) { const size_t off = (size_t)(rowl + ai * HALF + m * 16) * ldc + col0;
#pragma unroll
                for (int bj = 0; bj < 2; ++bj)
#pragma unroll
                    for (int n = 0; n < 2; ++n) { const f32x4 b = *(const f32x4*)(bp + off + bj * HALF + n * 16); *(f32x4*)(op + off + bj * HALF + n * 16) = b + acc[ai][bj][m][n]; } }
    }
};

struct EpiResNorm {
    static constexpr bool PERM = true, AFTER_DRAIN = false;
    const float* base0; const float* base1; int split_pm; float* out; int ldc; bf16_t* hn; const float* g; float* ssq;
    __device__ __forceinline__ void operator()(const f32x4 (&acc)[2][2][4][2], const Unit& u, int wr, int wc, int fr_, int fq_) const {
        int fr = fr_, fq = fq_; asm volatile("" : "+v"(fr), "+v"(fq));
        const int rowl = wr * 64 + fr, col0 = u.pn * BM + wc * 32 + 8 * fq;
        const float* bp = (u.pm < split_pm) ? base0 + (size_t)u.pm * BM * ldc : base1 + (size_t)(u.pm - split_pm) * BM * ldc;
        float* op = out + (size_t)u.pm * BM * ldc;
        f32x4 gv[2][2];
#pragma unroll
        for (int bj = 0; bj < 2; ++bj)
#pragma unroll
            for (int n = 0; n < 2; ++n) gv[bj][n] = hn ? *(const f32x4*)(g + col0 + bj * HALF + 4 * n) : (f32x4){0.f, 0.f, 0.f, 0.f};
#pragma unroll
        for (int ai = 0; ai < 2; ++ai)
#pragma unroll
            for (int m = 0; m < 4; ++m) { const int r = rowl + ai * HALF + m * 16; const size_t off = (size_t)r * ldc + col0; float sq = 0.f;
#pragma unroll
                for (int bj = 0; bj < 2; ++bj) {
                    const f32x4 x0 = *(const f32x4*)(bp + off + bj * HALF) + acc[ai][bj][m][0], x1 = *(const f32x4*)(bp + off + bj * HALF + 4) + acc[ai][bj][m][1];
                    *(f32x4*)(op + off + bj * HALF) = x0; *(f32x4*)(op + off + bj * HALF + 4) = x1;
                    sq += (x0[0] * x0[0] + x0[1] * x0[1]) + (x0[2] * x0[2] + x0[3] * x0[3]) + (x1[0] * x1[0] + x1[1] * x1[1]) + (x1[2] * x1[2] + x1[3] * x1[3]);
                    if (hn) { const f32x4 h0 = x0 * gv[bj][0], h1 = x1 * gv[bj][1];
                        u32x4 w; w.x = cvt_pk_bf16(h0[0], h0[1]); w.y = cvt_pk_bf16(h0[2], h0[3]); w.z = cvt_pk_bf16(h1[0], h1[1]); w.w = cvt_pk_bf16(h1[2], h1[3]);
                        *(u32x4*)(hn + (size_t)u.pm * BM * ldc + off + bj * HALF) = w; } }
                sq += __shfl_xor(sq, 16); sq += __shfl_xor(sq, 32);
                if (fq == 0) __hip_atomic_fetch_add(ssq + (size_t)u.pm * BM + r, sq, __ATOMIC_RELAXED, __HIP_MEMORY_SCOPE_AGENT);
                asm volatile("" ::: "memory"); }
    }
};

template <class Epi, class Sched, bool ALIGN_EPI = false, bool SP2 = false>
__device__ __forceinline__ void gemm_phase(PG8_LAS unsigned char* lds, const Gemm g, const Sched& S, const Epi& E) {
    int tid_ = threadIdx.x; asm volatile("" : "+v"(tid_));
    const int tid = tid_, wid = __builtin_amdgcn_readfirstlane(tid >> 6), lane = tid & 63, wr = wid >> 2, wc = wid & 3, fr = lane & 15, fq = lane >> 4;
    const int K = g.K, nt = K / BK;
    unsigned voffA[2], voffB[2];
#pragma unroll
    for (int i = 0; i < 2; ++i) { int R, C; stage_rc(tid * 16 + i * 8192, R, C); const int Rb = Epi::PERM ? ((R & ~31) + perm32(R & 31)) : R;
        voffA[i] = (unsigned)(R * K + C) * 2u; voffB[i] = (unsigned)(Rb * K + C) * 2u; }
    const size_t kstep = (size_t)(BK * 2);
    const size_t hstep = (size_t)HALF * K * 2;
    const size_t tstep = 2 * hstep;
    const unsigned ldsw = (unsigned)wid * 1024u;
    const int aoff = lds_byte(wr * 64 + fr, fq * 8), boff = lds_byte(wc * 32 + fr, fq * 8);
#define PG8_SA(b, h) (((b) * 2 + (h)) * HTB)
#define PG8_SB(b, h) ((4 + (b) * 2 + (h)) * HTB)
#define PG8_STAGE(bufoff, gbase, voff) do { _Pragma("unroll") for (int _i = 0; _i < 2; ++_i) \
        __builtin_amdgcn_global_load_lds((const unsigned*)((const char*)(gbase) + (voff)[_i]), (PG8_LAS unsigned*)(lds + (bufoff) + ldsw + _i * 8192), 16, 0, 0); } while (0)
#define PG8_LDA(dst, b, h) do { _Pragma("unroll") for (int m = 0; m < 4; ++m) _Pragma("unroll") for (int k = 0; k < 2; ++k) dst[m][k] = *(const PG8_LAS bf16x8*)(lds + PG8_SA(b, h) + aoff + m * 2048 + k * 1024); } while (0)
#define PG8_LDB(dst, b, h) do { _Pragma("unroll") for (int n = 0; n < 2; ++n) _Pragma("unroll") for (int k = 0; k < 2; ++k) dst[n][k] = *(const PG8_LAS bf16x8*)(lds + PG8_SB(b, h) + boff + n * 2048 + k * 1024); } while (0)
#define PG8_MMA(ai, bj, At, Bt) do { __builtin_amdgcn_s_setprio(1); _Pragma("unroll") for (int m = 0; m < 4; ++m) _Pragma("unroll") for (int n = 0; n < 2; ++n) _Pragma("unroll") for (int k = 0; k < 2; ++k) \
        acc[ai][bj][m][n] = __builtin_amdgcn_mfma_f32_16x16x32_bf16(Bt[n][k], At[m][k], acc[ai][bj][m][n], 0, 0, 0); __builtin_amdgcn_s_setprio(0); } while (0)
#define PG8_WAIT_V(n) asm volatile("s_waitcnt vmcnt(" #n ")" ::: "memory")
#define PG8_WAIT_L(n) asm volatile("s_waitcnt lgkmcnt(" #n ")" ::: "memory")
#define PG8_BAR __builtin_amdgcn_s_barrier()
#define PG8_SCHED __builtin_amdgcn_sched_barrier(0)
    Unit cur, nxt; int ui = 0;
    if (!S.next(0, cur)) return;
    f32x4 acc[2][2][4][2];
#pragma unroll
    for (int a = 0; a < 2; ++a)
#pragma unroll
        for (int b = 0; b < 2; ++b)
#pragma unroll
            for (int m = 0; m < 4; ++m)
#pragma unroll
                for (int n = 0; n < 2; ++n) acc[a][b][m][n] = (f32x4){0.f, 0.f, 0.f, 0.f};
    bf16x8 At[4][2], B0[2][2], B1[2][2];
    const char* cA = (const char*)g.A + (size_t)cur.pm * tstep; const char* cB = (const char*)g.Bt + (size_t)cur.pn * tstep;
    S.a_ready(cur);
    if constexpr (SP2) {
        PG8_STAGE(PG8_SB(0, 0), cB, voffB); PG8_STAGE(PG8_SB(0, 1), cB + hstep, voffB); PG8_STAGE(PG8_SA(0, 0), cA, voffA); PG8_STAGE(PG8_SA(0, 1), cA + hstep, voffA);
        if (wr == 1) PG8_BAR;
        PG8_WAIT_V(2); PG8_BAR;
        PG8_STAGE(PG8_SB(1, 0), cB + kstep, voffB); PG8_STAGE(PG8_SA(1, 0), cA + kstep, voffA); PG8_STAGE(PG8_SB(1, 1), cB + hstep + kstep, voffB);
        PG8_WAIT_V(6); PG8_BAR;
    } else {
        PG8_STAGE(PG8_SB(0, 0), cB, voffB); PG8_STAGE(PG8_SA(0, 0), cA, voffA); PG8_STAGE(PG8_SB(0, 1), cB + hstep, voffB); PG8_STAGE(PG8_SA(0, 1), cA + hstep, voffA);
        if (wr == 1) PG8_BAR;
        PG8_WAIT_V(4); PG8_BAR;
        PG8_STAGE(PG8_SB(1, 0), cB + kstep, voffB); PG8_STAGE(PG8_SA(1, 0), cA + kstep, voffA); PG8_STAGE(PG8_SB(1, 1), cB + hstep + kstep, voffB);
        PG8_WAIT_V(6); PG8_BAR;
    }
    for (;;) {
        const bool has_next = S.next(ui + 1, nxt);
        const char* nA = has_next ? (const char*)g.A + (size_t)nxt.pm * tstep : cA; const char* nB = has_next ? (const char*)g.Bt + (size_t)nxt.pn * tstep : cB;
        for (int t = 0; t < nt; t += 2) {
            const bool last = (t == nt - 2);
            const char* a1 = cA + (size_t)(t + 1) * kstep;
            const char* a2 = last ? nA : cA + (size_t)(t + 2) * kstep; const char* b2 = last ? nB : cB + (size_t)(t + 2) * kstep;
            const char* a3 = a2 + kstep; const char* b3 = b2 + kstep;
            if (last && has_next) S.a_ready(nxt);
            if constexpr (SP2) {
            PG8_LDB(B0, 0, 0); PG8_LDB(B1, 0, 1); PG8_SCHED; PG8_LDA(At, 0, 0); PG8_STAGE(PG8_SA(1, 1), a1 + hstep, voffA);
            PG8_WAIT_V(8); PG8_WAIT_L(0); PG8_BAR; PG8_MMA(0, 0, At, B0); PG8_MMA(0, 1, At, B1); PG8_BAR; PG8_SCHED;
            PG8_LDA(At, 0, 1); PG8_STAGE(PG8_SB(0, 0), b2, voffB); PG8_STAGE(PG8_SB(0, 1), b2 + hstep, voffB); PG8_STAGE(PG8_SA(0, 0), a2, voffA);
            PG8_WAIT_V(8); PG8_WAIT_L(0); PG8_BAR; PG8_MMA(1, 0, At, B0); PG8_MMA(1, 1, At, B1); PG8_BAR; PG8_SCHED;
            PG8_LDB(B0, 1, 0); PG8_LDB(B1, 1, 1); PG8_SCHED; PG8_LDA(At, 1, 0); PG8_STAGE(PG8_SA(0, 1), a2 + hstep, voffA);
            PG8_WAIT_V(8); PG8_WAIT_L(0); PG8_BAR; PG8_MMA(0, 0, At, B0); PG8_MMA(0, 1, At, B1); PG8_BAR; PG8_SCHED;
            PG8_LDA(At, 1, 1); PG8_STAGE(PG8_SB(1, 0), b3, voffB); PG8_STAGE(PG8_SB(1, 1), b3 + hstep, voffB); PG8_STAGE(PG8_SA(1, 0), a3, voffA);
            PG8_WAIT_V(8); PG8_WAIT_L(0); PG8_BAR; PG8_MMA(1, 0, At, B0); PG8_MMA(1, 1, At, B1); PG8_BAR; PG8_SCHED;
            } else {
            PG8_LDB(B0, 0, 0); PG8_SCHED; PG8_LDA(At, 0, 0); PG8_STAGE(PG8_SA(1, 1), a1 + hstep, voffA);
            PG8_WAIT_L(8); PG8_BAR; PG8_WAIT_L(0); PG8_MMA(0, 0, At, B0); PG8_BAR; PG8_SCHED;
            PG8_LDB(B1, 0, 1); PG8_STAGE(PG8_SB(0, 0), b2, voffB);
            PG8_BAR; PG8_WAIT_L(0); PG8_MMA(0, 1, At, B1); PG8_BAR;
            PG8_LDA(At, 0, 1); PG8_STAGE(PG8_SA(0, 0), a2, voffA);
            PG8_BAR; PG8_WAIT_L(0); PG8_MMA(1, 0, At, B0); PG8_BAR; PG8_SCHED;
            PG8_STAGE(PG8_SB(0, 1), b2 + hstep, voffB);
            PG8_WAIT_V(6); PG8_BAR; PG8_MMA(1, 1, At, B1); PG8_BAR;
            PG8_LDB(B0, 1, 0); PG8_SCHED; PG8_LDA(At, 1, 0); PG8_STAGE(PG8_SA(0, 1), a2 + hstep, voffA);
            PG8_WAIT_L(8); PG8_BAR; PG8_WAIT_L(0); PG8_MMA(0, 0, At, B0); PG8_BAR; PG8_SCHED;
            PG8_LDB(B1, 1, 1); PG8_STAGE(PG8_SB(1, 0), b3, voffB);
            PG8_BAR; PG8_WAIT_L(0); PG8_MMA(0, 1, At, B1); PG8_BAR;
            PG8_LDA(At, 1, 1); PG8_STAGE(PG8_SA(1, 0), a3, voffA);
            PG8_BAR; PG8_WAIT_L(0); PG8_MMA(1, 0, At, B0); PG8_BAR; PG8_SCHED;
            PG8_STAGE(PG8_SB(1, 1), b3 + hstep, voffB);
            PG8_WAIT_V(6); PG8_BAR; PG8_MMA(1, 1, At, B1); PG8_BAR;
            }
        }
        if constexpr (ALIGN_EPI) { if (wr == 0) PG8_BAR; }
        if constexpr (!Epi::AFTER_DRAIN) { E(acc, cur, wr, wc, fr, fq); S.done(cur); }
        if (!has_next) break;
#pragma unroll
        for (int a = 0; a < 2; ++a)
#pragma unroll
            for (int b = 0; b < 2; ++b)
#pragma unroll
                for (int m = 0; m < 4; ++m)
#pragma unroll
                    for (int n = 0; n < 2; ++n) acc[a][b][m][n] = (f32x4){0.f, 0.f, 0.f, 0.f};
        cur = nxt; cA = nA; cB = nB; ++ui;
        if constexpr (ALIGN_EPI) { if (wr == 1) PG8_BAR; }
    }
    PG8_WAIT_V(0);
    if constexpr (!ALIGN_EPI) { if (wr == 0) PG8_BAR; }
    PG8_BAR;
    if constexpr (Epi::AFTER_DRAIN) { E.fused(acc, cur, wr, wc, fr, fq, lds, wid, lane); S.done(cur); }
#undef PG8_SA
#undef PG8_SB
#undef PG8_STAGE
#undef PG8_LDA
#undef PG8_LDB
#undef PG8_MMA
#undef PG8_WAIT_V
#undef PG8_WAIT_L
#undef PG8_BAR
#undef PG8_SCHED
}
}

constexpr int NWAVES = 8;
constexpr int DM = 4096, MTOK = 32768, MPROMPT = 16384, SEQ_S = 2048;
constexpr int HD = 128, NHEAD = 16, AWID = 2048, BWID = 2048, INW = 10240, NMEMROWS = 2304, XW = 512, XHEADS = 4, DFF = 11008;
constexpr int QOFF = 4096, KOFF = 6144, VOFF = 8192;
constexpr float EPS = 1e-6f;
constexpr float LOG2E = 1.4426950408889634f;
constexpr float QSCALE = 0.08838834764831845f * LOG2E;

constexpr size_t MiB = 1u << 20;
constexpr size_t WS_CTL = 0, CTL_ZERO_BYTES = 1 * MiB;
constexpr size_t WS_SGW = 1 * MiB;
constexpr size_t WS_WIN = 2 * MiB, WS_WOUT = 82 * MiB, WS_WXQ = 114 * MiB, WS_WXKV = 118 * MiB, WS_WXO = 126 * MiB, WS_WUP = 130 * MiB, WS_WDN = 302 * MiB;
constexpr size_t WS_HN = 388 * MiB;
constexpr size_t WS_PROJ = 644 * MiB;
constexpr size_t WS_MEMN = 1284 * MiB;
constexpr size_t WS_KVX = 1302 * MiB;
constexpr size_t WS_END = 1307 * MiB;
constexpr size_t PJ_QX = 0, PJ_OX = 32 * MiB, PJ_H2 = 64 * MiB;
constexpr size_t PJ_Z = 0, PJ_G = 368 * MiB;
constexpr size_t OUT_OP = 0, OP_STRIDE = 128 * MiB, OUT_LSE = 384 * MiB;
constexpr int CW_BAR = 4096;
constexpr int CW_SSQ1 = 16384, CW_SSQ2 = CW_SSQ1 + MTOK, CW_SSQ3 = CW_SSQ2 + MTOK;
static_assert((CW_SSQ3 + MTOK) * 4 <= (int)CTL_ZERO_BYTES, "CTL words inside the memset region");

constexpr int RING_OFF = 0, RING_BYTES = 131072;
constexpr int LDSCTL_OFF = RING_BYTES, MISC_OFF = LDSCTL_OFF + 320;
constexpr int LDS_BYTES = 147456;
constexpr int IMG_PITCH = 320;

#define GAS __attribute__((address_space(1)))
#define LAS __attribute__((address_space(3)))
typedef unsigned short bf16;
typedef unsigned v4u __attribute__((ext_vector_type(4)));
typedef unsigned v2u __attribute__((ext_vector_type(2)));
typedef float f32x4 __attribute__((ext_vector_type(4)));
typedef float f32x16 __attribute__((ext_vector_type(16)));
typedef short bf16x8 __attribute__((ext_vector_type(8)));
typedef short s16x4 __attribute__((ext_vector_type(4)));
typedef GAS unsigned gu32;
#define RLX_AGENT __ATOMIC_RELAXED, __HIP_MEMORY_SCOPE_AGENT
#define LDS_WAIT() asm volatile("s_waitcnt lgkmcnt(0)" ::: "memory")
#define VM_WAIT() asm volatile("s_waitcnt vmcnt(0)" ::: "memory")
#define SBAR() __builtin_amdgcn_sched_barrier(0)
__device__ __forceinline__ unsigned pk2(float lo, float hi) { return pg8::cvt_pk_bf16(lo, hi); }
__device__ __forceinline__ float bflo(unsigned w) { return __uint_as_float(w << 16); }
__device__ __forceinline__ float bfhi(unsigned w) { return __uint_as_float(w & 0xffff0000u); }

#define XB_TMO      128
#define XB_XCNT(j)  (256  + 64 * (j))
#define XB_XSUB(j)  (1280 + 64 * (j))
#define XB_XGEN(j)  (2304 + 64 * (j))
#define XB_TOP      3328
#define XB_TOPGEN   3392
#define XCD_BAR_WORDS 3456
#define XB_SPIN_CAP (1u << 23)

__device__ __forceinline__ unsigned xb_ld(unsigned* p)              { return __hip_atomic_load(p, __ATOMIC_RELAXED, __HIP_MEMORY_SCOPE_AGENT); }
__device__ __forceinline__ unsigned xb_add(unsigned* p, unsigned v) { return __hip_atomic_fetch_add(p, v, __ATOMIC_RELAXED, __HIP_MEMORY_SCOPE_AGENT); }
__device__ __forceinline__ unsigned xb_xcc_id() { return (unsigned)__builtin_amdgcn_s_getreg((3 << 11) | 20) & 0xFu; }
#define XB_SPIN(cond, bar) do { unsigned _sp = 0; while (cond) { __builtin_amdgcn_s_sleep(1); \
    if ((++_sp & 255u) == 0u) { if (xb_ld(&(bar)[XB_TMO])) break; if (_sp > XB_SPIN_CAP) { atomicAdd(&(bar)[XB_TMO], 1u); break; } } } } while (0)

struct XcdBarrier { unsigned* bar; unsigned x; volatile LAS unsigned* st; };

__device__ __forceinline__ XcdBarrier xcd_barrier_post(unsigned* bar, volatile LAS unsigned* st) {
    XcdBarrier b; b.bar = bar; b.x = xb_xcc_id(); b.st = st;
    if (threadIdx.x == 0) (void)xb_add(&bar[XB_XCNT(b.x)], 1u);
    return b;
}
__device__ __forceinline__ void xcd_barrier_complete(unsigned* bar, unsigned x, unsigned& nloc, unsigned& nx) {
    const unsigned G = gridDim.x * gridDim.y * gridDim.z;
    unsigned sum, cnt, mine, sp = 0u;
    for (;;) {
        sum = 0u; cnt = 0u; mine = 0u;
#pragma unroll
        for (unsigned j = 0; j < 16; ++j) { const unsigned c = xb_ld(&bar[XB_XCNT(j)]); sum += c; cnt += (c > 0u) ? 1u : 0u; mine = (j == x) ? c : mine; }
        if (sum == G) break;
        __builtin_amdgcn_s_sleep(1);
        if ((++sp & 255u) == 0u) { if (xb_ld(&bar[XB_TMO])) break; if (sp > XB_SPIN_CAP) { atomicAdd(&bar[XB_TMO], 1u); break; } }
    }
    nloc = mine > 0u ? mine : 1u; nx = cnt > 0u ? cnt : 1u;
}
__device__ __forceinline__ void xcd_barrier(const XcdBarrier& b) {
    asm volatile("s_waitcnt vmcnt(0)" ::: "memory");
    __syncthreads();
    if (threadIdx.x == 0) {
        unsigned* bar = b.bar;
        __builtin_amdgcn_s_waitcnt(0);
        unsigned nloc = b.st[0], nx = b.st[1];
        if (nloc == 0u) { xcd_barrier_complete(bar, b.x, nloc, nx); b.st[0] = nloc; b.st[1] = nx; }
        const unsigned old = xb_add(&bar[XB_XSUB(b.x)], 1u);
        const unsigned gen = old / nloc;
        if (old + 1u == (gen + 1u) * nloc) {
            __builtin_amdgcn_fence(__ATOMIC_RELEASE, "agent");
            asm volatile("s_waitcnt vmcnt(0)" ::: "memory");
            const unsigned og = xb_add(&bar[XB_TOP], 1u);
            const unsigned tg = og / nx;
            if (og + 1u == (tg + 1u) * nx) xb_add(&bar[XB_TOPGEN], 1u);
            else XB_SPIN(xb_ld(&bar[XB_TOPGEN]) == tg, bar);
            __builtin_amdgcn_fence(__ATOMIC_ACQUIRE, "agent");
            xb_add(&bar[XB_XGEN(b.x)], 1u);
            asm volatile("s_waitcnt vmcnt(0)" ::: "memory");
        } else {
            XB_SPIN(xb_ld(&bar[XB_XGEN(b.x)]) == gen, bar);
            __builtin_amdgcn_fence(__ATOMIC_ACQUIRE, "agent");
            asm volatile("s_waitcnt vmcnt(0)" ::: "memory");
        }
    }
    __syncthreads();
}

__device__ __forceinline__ float wave_sum(float v) {
#pragma unroll
    for (int o = 1; o < 64; o <<= 1) v += __shfl_xor(v, o);
    return v;
}
__device__ __forceinline__ float half_swap_sum(float v) { const auto rr = __builtin_amdgcn_permlane32_swap(__float_as_uint(v), __float_as_uint(v), false, false); return __uint_as_float(rr[0]) + __uint_as_float(rr[1]); }
__device__ __forceinline__ float half_swap_max(float v) { const auto rr = __builtin_amdgcn_permlane32_swap(__float_as_uint(v), __float_as_uint(v), false, false); return fmaxf(__uint_as_float(rr[0]), __uint_as_float(rr[1])); }
__device__ __forceinline__ int crow(int r, int hi) { return (r & 3) + 8 * (r >> 2) + 4 * hi; }
__device__ __forceinline__ s16x4 tr_read(unsigned addr) { s16x4 r; asm volatile("ds_read_b64_tr_b16 %0, %1" : "=&v"(r) : "v"(addr) : "memory"); return r; }
#define PK8(L, H) (bf16x8){L[0], L[1], L[2], L[3], H[0], H[1], H[2], H[3]}

__device__ __forceinline__ void p0_transpose_item(const float* W, int K, int N, bf16* WT, LAS float* scr, int item, int lane) {
    const int nblk = N / 32, kb = item / nblk, nb = item % nblk, k0 = 64 * kb, n0 = 32 * nb;
#pragma unroll 8
    for (int i = 0; i < 32; ++i) { const int kk = 2 * i + (lane >> 5); scr[kk * 33 + (lane & 31)] = W[(size_t)(k0 + kk) * N + n0 + (lane & 31)]; }
    LDS_WAIT(); asm volatile("" ::: "memory");
    const int c = lane & 7;
#pragma unroll
    for (int j = 0; j < 4; ++j) { const int n = (lane >> 3) + 8 * j; const LAS float* s = scr + (8 * c) * 33 + n;
        v4u o; o.x = pk2(s[0 * 33], s[1 * 33]); o.y = pk2(s[2 * 33], s[3 * 33]); o.z = pk2(s[4 * 33], s[5 * 33]); o.w = pk2(s[6 * 33], s[7 * 33]);
        *(GAS v4u*)(WT + (size_t)(n0 + n) * K + k0 + 8 * c) = o; }
    LDS_WAIT(); asm volatile("" ::: "memory");
}
__device__ __forceinline__ void rms_row_to_bf16(const float* xrow, const float* g, bf16* orow, int lane) {
    const GAS f32x4* xr = (const GAS f32x4*)xrow + lane; const GAS f32x4* gr = (const GAS f32x4*)g + lane;
    f32x4 v[16]; float s = 0.f;
#pragma unroll
    for (int j = 0; j < 16; ++j) { v[j] = xr[64 * j]; s += (v[j].x * v[j].x + v[j].y * v[j].y) + (v[j].z * v[j].z + v[j].w * v[j].w); }
    const float rstd = 1.0f / sqrtf(wave_sum(s) * (1.f / DM) + EPS);
    GAS v2u* o8 = (GAS v2u*)orow + lane;
#pragma unroll
    for (int j = 0; j < 16; ++j) { const f32x4 gg = gr[64 * j]; v2u w; w.x = pk2(v[j].x * rstd * gg.x, v[j].y * rstd * gg.y); w.y = pk2(v[j].z * rstd * gg.z, v[j].w * rstd * gg.w); o8[64 * j] = w; }
}
__device__ __forceinline__ void rms_row_inplace(float* xrow, const float* g, int lane) {
    GAS f32x4* xr = (GAS f32x4*)xrow + lane; const GAS f32x4* gr = (const GAS f32x4*)g + lane;
    f32x4 v[16]; float s = 0.f;
#pragma unroll
    for (int j = 0; j < 16; ++j) { v[j] = xr[64 * j]; s += (v[j].x * v[j].x + v[j].y * v[j].y) + (v[j].z * v[j].z + v[j].w * v[j].w); }
    const float rstd = 1.0f / sqrtf(wave_sum(s) * (1.f / DM) + EPS);
#pragma unroll
    for (int j = 0; j < 16; ++j) { const f32x4 gg = gr[64 * j]; xr[64 * j] = v[j] * rstd * gg; }
}

template <bool DIL>
__device__ __forceinline__ void attn_tile(f32x16 (&o)[4], float& m, float& l, const bf16x8 (&qf)[8], const bf16* kp, const bf16* vp, size_t vstride4, LAS unsigned char* img, float slope2d, int lane, int kt) {
    const int c = lane & 31, hi = lane >> 5;
    bf16x8 kf[8]; v4u vr[8];
#pragma unroll
    for (int ks = 0; ks < 8; ++ks) kf[ks] = *(const GAS bf16x8*)(kp + 16 * ks);
#pragma unroll
    for (int i = 0; i < 8; ++i) vr[i] = *(const GAS v4u*)(vp + (size_t)i * vstride4);
    f32x16 s;
#pragma unroll
    for (int i = 0; i < 16; ++i) s[i] = 0.f;
#pragma unroll
    for (int ks = 0; ks < 8; ++ks) s = __builtin_amdgcn_mfma_f32_32x32x16_bf16(kf[ks], qf[ks], s, 0, 0, 0);
    LAS unsigned char* wp = img + (lane >> 4) * IMG_PITCH + 16 * (lane & 15);
#pragma unroll
    for (int i = 0; i < 8; ++i) *(LAS v4u*)(wp + 4 * i * IMG_PITCH) = vr[i];
    if (DIL) {
        const int dbase = 32 * kt + 4 * hi - c;
#pragma unroll
        for (int i = 0; i < 16; ++i) { const int diff = dbase + crow(i, 0); const int adi = diff < 0 ? -diff : diff;
            const float v = s[i] - slope2d * (float)adi;
            s[i] = (adi <= 64) ? v : -1e30f; }
    }
    float mx = s[0];
#pragma unroll
    for (int i = 1; i < 16; ++i) mx = fmaxf(mx, s[i]);
    mx = half_swap_max(mx);
    const float mn = fmaxf(m, mx), alpha = __builtin_amdgcn_exp2f(m - mn);
    float ps = 0.f;
#pragma unroll
    for (int i = 0; i < 16; ++i) { s[i] = __builtin_amdgcn_exp2f(s[i] - mn); ps += s[i]; }
    ps = half_swap_sum(ps);
    l = l * alpha + ps; m = mn;
#pragma unroll
    for (int d = 0; d < 4; ++d)
#pragma unroll
        for (int i = 0; i < 16; ++i) o[d][i] *= alpha;
    v4u w0, w1;
    w0.x = pk2(s[0], s[1]); w0.y = pk2(s[2], s[3]); w0.z = pk2(s[4], s[5]); w0.w = pk2(s[6], s[7]);
    w1.x = pk2(s[8], s[9]); w1.y = pk2(s[10], s[11]); w1.z = pk2(s[12], s[13]); w1.w = pk2(s[14], s[15]);
    const bf16x8 pb0 = __builtin_bit_cast(bf16x8, w0), pb1 = __builtin_bit_cast(bf16x8, w1);
    const unsigned rb = (unsigned)(uintptr_t)img + (unsigned)((4 * hi + ((lane & 15) >> 2)) * IMG_PITCH + 32 * ((lane >> 4) & 1) + 8 * (lane & 3));
    LDS_WAIT(); SBAR();
#pragma unroll
    for (int s2 = 0; s2 < 2; ++s2) {
        s16x4 a[4][2];
#pragma unroll
        for (int d = 0; d < 4; ++d)
#pragma unroll
            for (int t = 0; t < 2; ++t) a[d][t] = tr_read(rb + (unsigned)((16 * s2 + 8 * t) * IMG_PITCH + 64 * d));
        LDS_WAIT(); SBAR();
#pragma unroll
        for (int d = 0; d < 4; ++d) o[d] = __builtin_amdgcn_mfma_f32_32x32x16_bf16(PK8(a[d][0], a[d][1]), s2 ? pb1 : pb0, o[d], 0, 0, 0);
    }
}

__device__ __forceinline__ void attn_store(const f32x16 (&o)[4], float l, bf16* orow, int hi) {
    const float inv = 1.0f / l;
#pragma unroll
    for (int d = 0; d < 4; ++d)
#pragma unroll
        for (int g4 = 0; g4 < 4; ++g4) { v2u w; w.x = pk2(o[d][4 * g4] * inv, o[d][4 * g4 + 1] * inv); w.y = pk2(o[d][4 * g4 + 2] * inv, o[d][4 * g4 + 3] * inv);
            *(GAS v2u*)(orow + 32 * d + 8 * g4 + 4 * hi) = w; }
}

struct Args { const float* in[24]; float* out; unsigned char* ws; int ph_lo, ph_hi; };
enum { I_XP = 0, I_XS, I_MEMP, I_MEMS, I_NMIXG, I_WIN, I_SGLNG, I_SGLNB, I_SGW, I_SGB, I_GAG, I_GBG, I_WOUT, I_NXG, I_MEMG, I_WXQ, I_WXKV, I_WXO, I_NFFNG, I_WUP, I_CONVW, I_CONVB, I_WDN, I_FING };

__global__ void __launch_bounds__(NWAVES * 64, 2) fwd_kernel(Args args) {
    extern __shared__ __attribute__((aligned(16))) unsigned char lds_raw[];
    LAS unsigned char* lds = (LAS unsigned char*)lds_raw;
    volatile LAS unsigned* MISC = (volatile LAS unsigned*)(lds + MISC_OFF);
    const int tid = threadIdx.x, lane = tid & 63, wave = __builtin_amdgcn_readfirstlane(tid >> 6);
    const int G = gridDim.x, gw = blockIdx.x * NWAVES + wave, NGW = G * NWAVES;
    unsigned char* ws = args.ws;
    gu32* ctl = (gu32*)(ws + WS_CTL);
    bf16* SGWB = (bf16*)(ws + WS_SGW);
    bf16* Win_t = (bf16*)(ws + WS_WIN); bf16* Wout_t = (bf16*)(ws + WS_WOUT); bf16* Wxq_t = (bf16*)(ws + WS_WXQ); bf16* Wxkv_t = (bf16*)(ws + WS_WXKV);
    bf16* Wxo_t = (bf16*)(ws + WS_WXO); bf16* Wup_t = (bf16*)(ws + WS_WUP); bf16* Wdn_t = (bf16*)(ws + WS_WDN);
    bf16* HN = (bf16*)(ws + WS_HN); bf16* PROJ = (bf16*)(ws + WS_PROJ); bf16* MEMN = (bf16*)(ws + WS_MEMN); bf16* KVX = (bf16*)(ws + WS_KVX);
    bf16* QX = (bf16*)(ws + WS_PROJ + PJ_QX); bf16* OX = (bf16*)(ws + WS_PROJ + PJ_OX); bf16* ZB = (bf16*)(ws + WS_PROJ + PJ_Z); bf16* GB = (bf16*)(ws + WS_PROJ + PJ_G);
    float* OUT = args.out;
    unsigned char* outb = (unsigned char*)args.out;
    float* LSE = (float*)(outb + OUT_LSE);
    bf16* H2 = (bf16*)(ws + WS_PROJ + PJ_H2);
    float* SSQ1 = (float*)(ws + WS_CTL) + CW_SSQ1; float* SSQ2 = (float*)(ws + WS_CTL) + CW_SSQ2; float* SSQ3 = (float*)(ws + WS_CTL) + CW_SSQ3;

    for (int u = tid; u < (LDS_BYTES - LDSCTL_OFF) / 4; u += NWAVES * 64) ((LAS unsigned*)(lds + LDSCTL_OFF))[u] = 0u;
    __syncthreads();
    XcdBarrier bar = xcd_barrier_post((unsigned*)(ctl + CW_BAR), MISC + 8);
#define GRID_BAR() xcd_barrier(bar)
    const int lo = args.ph_lo, hi_ph = args.ph_hi;
#ifdef PHMASK
#define IN(k) ((PHMASK >> (k)) & 1)
#else
#define IN(k) (lo <= (k) && (k) < hi_ph)
#endif

    if (IN(0)) {
        LAS float* scr = (LAS float*)(lds + RING_OFF + wave * 16384);
        constexpr int I_1 = (DM / 64) * (INW / 32), I_2 = (DM / 64) * (DM / 32), I_3 = (DM / 64) * (XW / 32), I_4 = (DM / 64) * (2 * XW / 32), I_5 = (XW / 64) * (DM / 32),
                      I_6 = (DM / 64) * (2 * DFF / 32), I_7 = (DFF / 64) * (DM / 32);
        constexpr int NITEMS = I_1 + I_2 + I_3 + I_4 + I_5 + I_6 + I_7;
        for (int it = gw; it < NITEMS; it += NGW) {
            int r = it;
            if (r < I_1) { p0_transpose_item(args.in[I_WIN], DM, INW, Win_t, scr, r, lane); continue; } r -= I_1;
            if (r < I_2) { p0_transpose_item(args.in[I_WOUT], DM, DM, Wout_t, scr, r, lane); continue; } r -= I_2;
            if (r < I_3) { p0_transpose_item(args.in[I_WXQ], DM, XW, Wxq_t, scr, r, lane); continue; } r -= I_3;
            if (r < I_4) { p0_transpose_item(args.in[I_WXKV], DM, 2 * XW, Wxkv_t, scr, r, lane); continue; } r -= I_4;
            if (r < I_5) { p0_transpose_item(args.in[I_WXO], XW, DM, Wxo_t, scr, r, lane); continue; } r -= I_5;
            if (r < I_6) { p0_transpose_item(args.in[I_WUP], DM, 2 * DFF, Wup_t, scr, r, lane); continue; } r -= I_6;
            p0_transpose_item(args.in[I_WDN], DFF, DM, Wdn_t, scr, r, lane);
        }
        for (int i = blockIdx.x * 512 + tid; i < NHEAD * 128 * 128 / 2; i += G * 512) { const float2 v = ((const float2*)args.in[I_SGW])[i]; ((unsigned*)SGWB)[i] = pk2(v.x, v.y); }
        for (int mrow = gw; mrow < MTOK; mrow += NGW) {
            const float* xr = mrow < MPROMPT ? args.in[I_XP] + (size_t)mrow * DM : args.in[I_XS] + (size_t)(mrow - MPROMPT) * DM;
            rms_row_to_bf16(xr, args.in[I_NMIXG], HN + (size_t)mrow * DM, lane); }
        for (int mrow = gw; mrow < NMEMROWS; mrow += NGW) {
            const float* xr = mrow < 256 ? args.in[I_MEMP] + (size_t)mrow * DM : args.in[I_MEMS] + (size_t)(mrow - 256) * DM;
            rms_row_to_bf16(xr, args.in[I_MEMG], MEMN + (size_t)mrow * DM, lane); }
        GRID_BAR();
    }

    if (IN(1)) {
        { pg8::Gemm g{HN, Win_t, MTOK, INW, DM}; pg8::StaticOrder S; S.init(MTOK, INW, G, (int)blockIdx.x);
          pg8::EpiInProj E{PROJ, INW, QSCALE};
          pg8::gemm_phase<pg8::EpiInProj, pg8::StaticOrder, true, true>(lds + RING_OFF, g, S, E); }
        { pg8::Gemm g{MEMN, Wxkv_t, NMEMROWS, 2 * XW, DM}; pg8::StaticOrder S; S.init(NMEMROWS, 2 * XW, G, (int)blockIdx.x);
          pg8::EpiBf16S E{KVX, 2 * XW, 1.0f, nullptr};
          pg8::gemm_phase<pg8::EpiBf16S, pg8::StaticOrder, true, true>(lds + RING_OFF, g, S, E); }
        GRID_BAR();
    }

    if (IN(2)) {
#ifndef NO_SG
        LAS float* stat_mean = (LAS float*)(lds + 81920); LAS float* stat_rstd = stat_mean + 128; LAS float* ssqL = stat_mean + 256;
        const float* lng = args.in[I_SGLNG]; const float* lnb = args.in[I_SGLNB]; const float* sgb = args.in[I_SGB]; const float* gag = args.in[I_GAG];
        for (int ck = blockIdx.x; ck < MTOK / 128; ck += G) {
            const int R0 = ck * 128;
#pragma unroll 4
            for (int rr = 0; rr < 16; ++rr) { const int srow = wave * 16 + rr; const GAS v4u* vp = (const GAS v4u*)(PROJ + (size_t)(R0 + srow) * INW + AWID) + lane;
                float x[32]; float sm = 0.f;
#pragma unroll
                for (int j = 0; j < 4; ++j) { const v4u w = vp[64 * j];
                    x[8 * j + 0] = bflo(w.x); x[8 * j + 1] = bfhi(w.x); x[8 * j + 2] = bflo(w.y); x[8 * j + 3] = bfhi(w.y); x[8 * j + 4] = bflo(w.z); x[8 * j + 5] = bfhi(w.z); x[8 * j + 6] = bflo(w.w); x[8 * j + 7] = bfhi(w.w); }
#pragma unroll
                for (int j = 0; j < 32; ++j) sm += x[j];
                const float mean = wave_sum(sm) * (1.f / AWID); float sq = 0.f;
#pragma unroll
                for (int j = 0; j < 32; ++j) { const float d = x[j] - mean; sq += d * d; }
                const float rstd = 1.0f / sqrtf(wave_sum(sq) * (1.f / AWID) + EPS);
                if (lane == 0) { stat_mean[srow] = mean; stat_rstd[srow] = rstd; } }
            __syncthreads();
            const int hh = wave >> 2, tb = wave & 3, c = lane & 31, hi = lane >> 5;
            float ssq = 0.f;
            for (int hp = 0; hp < 8; ++hp) {
                { const int ch32 = tid & 31, colbase = 256 * hp + 8 * ch32;
                  float gv[8], bv[8];
#pragma unroll
                  for (int j = 0; j < 8; ++j) { gv[j] = lng[colbase + j]; bv[j] = lnb[colbase + j]; }
                  LAS unsigned char* ib = lds + (ch32 >> 4) * (128 * IMG_PITCH) + 16 * (ch32 & 15);
#pragma unroll
                  for (int i = 0; i < 8; ++i) { const int srow = (tid >> 5) + 16 * i;
                      const v4u w = *(const GAS v4u*)(PROJ + (size_t)(R0 + srow) * INW + AWID + colbase);
                      const float mu = stat_mean[srow], rs = stat_rstd[srow];
                      v4u o;
                      o.x = pk2((bflo(w.x) - mu) * rs * gv[0] + bv[0], (bfhi(w.x) - mu) * rs * gv[1] + bv[1]);
                      o.y = pk2((bflo(w.y) - mu) * rs * gv[2] + bv[2], (bfhi(w.y) - mu) * rs * gv[3] + bv[3]);
                      o.z = pk2((bflo(w.z) - mu) * rs * gv[4] + bv[4], (bfhi(w.z) - mu) * rs * gv[5] + bv[5]);
                      o.w = pk2((bflo(w.w) - mu) * rs * gv[6] + bv[6], (bfhi(w.w) - mu) * rs * gv[7] + bv[7]);
                      *(LAS v4u*)(ib + srow * IMG_PITCH) = o; } }
                __syncthreads();
                { int lz = lane; asm volatile("" : "+v"(lz)); const int c = lz & 31, hi = lz >> 5;
                  const int g = 2 * hp + hh, t = 32 * tb + c;
                  bf16x8 wf[8];
                  const bf16* wrow = SGWB + ((size_t)(g * 128 + t)) * 128 + 8 * hi;
#pragma unroll
                  for (int ks = 0; ks < 8; ++ks) wf[ks] = *(const GAS bf16x8*)(wrow + 16 * ks);
                  f32x16 acc[4];
#pragma unroll
                  for (int d = 0; d < 4; ++d)
#pragma unroll
                      for (int i = 0; i < 16; ++i) acc[d][i] = 0.f;
                  const unsigned rb = (unsigned)(uintptr_t)(lds + hh * (128 * IMG_PITCH)) + (unsigned)((8 * hi + ((lz & 15) >> 2)) * IMG_PITCH + 32 * ((lz >> 4) & 1) + 8 * (lz & 3));
#pragma unroll
                  for (int ks = 0; ks < 8; ++ks) {
                      s16x4 a[4][2];
#pragma unroll
                      for (int d = 0; d < 4; ++d)
#pragma unroll
                          for (int tt = 0; tt < 2; ++tt) a[d][tt] = tr_read(rb + (unsigned)((16 * ks + 4 * tt) * IMG_PITCH + 64 * d));
                      LDS_WAIT(); SBAR();
#pragma unroll
                      for (int d = 0; d < 4; ++d) acc[d] = __builtin_amdgcn_mfma_f32_32x32x16_bf16(PK8(a[d][0], a[d][1]), wf[ks], acc[d], 0, 0, 0);
                  }
                  const float bs = sgb[g * 128 + t];
                  const bf16* urow = PROJ + (size_t)(R0 + t) * INW + g * 128 + 4 * hi;
                  bf16* orow = HN + (size_t)(R0 + t) * DM + g * 128 + 4 * hi;
#pragma unroll
                  for (int d = 0; d < 4; ++d)
#pragma unroll
                      for (int g4 = 0; g4 < 4; ++g4) { const v2u uu = *(const GAS v2u*)(urow + 32 * d + 8 * g4);
                          const float a0 = bflo(uu.x) * (acc[d][4 * g4] + bs), a1 = bfhi(uu.x) * (acc[d][4 * g4 + 1] + bs), a2 = bflo(uu.y) * (acc[d][4 * g4 + 2] + bs), a3 = bfhi(uu.y) * (acc[d][4 * g4 + 3] + bs);
                          ssq += (a0 * a0 + a1 * a1) + (a2 * a2 + a3 * a3);
                          v2u w; w.x = pk2(a0, a1); w.y = pk2(a2, a3); *(GAS v2u*)(orow + 32 * d + 8 * g4) = w; }
                }
                __syncthreads();
            }
            ssq = half_swap_sum(ssq);
            if (hi == 0) ssqL[hh * 128 + 32 * tb + c] = ssq;
            VM_WAIT();
            __syncthreads();
            { const int cc = tid & 255;
              float gg[8];
#pragma unroll
              for (int j = 0; j < 8; ++j) gg[j] = gag[8 * cc + j];
#pragma unroll 8
              for (int i = 0; i < 64; ++i) { const int t = (tid >> 8) + 2 * i; const float rs = 1.0f / sqrtf((ssqL[t] + ssqL[128 + t]) * (1.f / AWID) + EPS);
                  GAS v4u* p = (GAS v4u*)(HN + (size_t)(R0 + t) * DM + 8 * cc); const v4u w = *p; v4u o;
                  o.x = pk2(bflo(w.x) * rs * gg[0], bfhi(w.x) * rs * gg[1]); o.y = pk2(bflo(w.y) * rs * gg[2], bfhi(w.y) * rs * gg[3]);
                  o.z = pk2(bflo(w.z) * rs * gg[4], bfhi(w.z) * rs * gg[5]); o.w = pk2(bflo(w.w) * rs * gg[6], bfhi(w.w) * rs * gg[7]); *p = o; } }
            __syncthreads();
        }
#endif
#ifndef NO_DIL
        { LAS unsigned char* img = lds + wave * (32 * IMG_PITCH);
          const int c = lane & 31, hi = lane >> 5;
          constexpr int NITEM = 3 * NHEAD * (MTOK / 32);
          const int ipw = (NITEM + NGW - 1) / NGW; const int it0 = gw * ipw, it1 = (it0 + ipw < NITEM) ? it0 + ipw : NITEM;
          for (int it = it0; it < it1; ++it) {
              const int p = it / (NHEAD * 1024), rem = it % (NHEAD * 1024), h = rem / 1024, tbk = rem % 1024;
              const int d = (p == 0) ? 1 : (p == 1 ? 4 : 16);
              int base, S, local;
              if (tbk < 512) { base = 0; S = MPROMPT; local = tbk; } else { base = MPROMPT + SEQ_S * ((tbk - 512) >> 6); S = SEQ_S; local = (tbk - 512) & 63; }
              const int nq = S / d, bpr = nq / 32, r = local / bpr, qb = local % bpr;
              const float slope2d = __builtin_amdgcn_exp2f(-0.5f * (float)(h + 1)) * LOG2E * (float)d;
              const size_t rowq = (size_t)(base + (32 * qb + c) * d + r);
              bf16x8 qf[8];
              { const bf16* qp = PROJ + rowq * INW + QOFF + h * HD + 8 * hi;
#pragma unroll
                for (int ks = 0; ks < 8; ++ks) qf[ks] = *(const GAS bf16x8*)(qp + 16 * ks); }
              f32x16 o[4];
#pragma unroll
              for (int dd = 0; dd < 4; ++dd)
#pragma unroll
                  for (int i = 0; i < 16; ++i) o[dd][i] = 0.f;
              float m = -1e30f, l = 0.f;
              const size_t vstride4 = (size_t)4 * d * INW;
#pragma unroll 1
              for (int j = 0; j < 5; ++j) { const int kt = (j & 1) ? -((j + 1) >> 1) : (j >> 1);
                  const int n0 = 32 * (qb + kt); if (n0 < 0 || n0 >= nq) continue;
                  const bf16* kp = PROJ + (size_t)(base + (n0 + c) * d + r) * INW + KOFF + h * HD + 8 * hi;
                  const bf16* vp = PROJ + (size_t)(base + (n0 + (lane >> 4)) * d + r) * INW + VOFF + h * HD + 8 * (lane & 15);
                  attn_tile<true>(o, m, l, qf, kp, vp, vstride4, img, slope2d, lane, kt); }
              attn_store(o, l, (bf16*)(outb + OUT_OP + (size_t)p * OP_STRIDE) + rowq * BWID + h * HD, hi);
              if (hi == 0) LSE[((size_t)p * MTOK + rowq) * NHEAD + h] = m + __builtin_amdgcn_logf(l);
          } }
#endif
        GRID_BAR();
    }

    if (IN(3)) {
        const float* gbg = args.in[I_GBG];
        for (int row = gw; row < MTOK; row += NGW) {
            const int h = lane >> 2;
            const float l0 = LSE[((size_t)0 * MTOK + row) * NHEAD + h], l1 = LSE[((size_t)1 * MTOK + row) * NHEAD + h], l2 = LSE[((size_t)2 * MTOK + row) * NHEAD + h];
            const float mx = fmaxf(l0, fmaxf(l1, l2));
            float w0 = __builtin_amdgcn_exp2f(l0 - mx), w1 = __builtin_amdgcn_exp2f(l1 - mx), w2 = __builtin_amdgcn_exp2f(l2 - mx);
            const float inv = 1.0f / (w0 + w1 + w2); w0 *= inv; w1 *= inv; w2 *= inv;
            float b[32];
#pragma unroll
            for (int j = 0; j < 32; ++j) b[j] = 0.f;
#pragma unroll
            for (int p = 0; p < 3; ++p) { const float wp = p == 0 ? w0 : (p == 1 ? w1 : w2);
                const GAS v4u* op = (const GAS v4u*)((const bf16*)(outb + OUT_OP + (size_t)p * OP_STRIDE) + (size_t)row * BWID + 32 * lane);
#pragma unroll
                for (int j = 0; j < 4; ++j) { const v4u w = op[j];
                    b[8 * j + 0] += wp * bflo(w.x); b[8 * j + 1] += wp * bfhi(w.x); b[8 * j + 2] += wp * bflo(w.y); b[8 * j + 3] += wp * bfhi(w.y);
                    b[8 * j + 4] += wp * bflo(w.z); b[8 * j + 5] += wp * bfhi(w.z); b[8 * j + 6] += wp * bflo(w.w); b[8 * j + 7] += wp * bfhi(w.w); } }
            float sq = 0.f;
#pragma unroll
            for (int j = 0; j < 32; ++j) sq += b[j] * b[j];
            const float rs = 1.0f / sqrtf(wave_sum(sq) * (1.f / BWID) + EPS);
            GAS v4u* dst = (GAS v4u*)(HN + (size_t)row * DM + AWID + 32 * lane);
            const GAS f32x4* gp = (const GAS f32x4*)(gbg + 32 * lane);
#pragma unroll
            for (int j = 0; j < 4; ++j) { const f32x4 ga = gp[2 * j], gc = gp[2 * j + 1]; v4u o;
                o.x = pk2(b[8 * j + 0] * rs * ga.x, b[8 * j + 1] * rs * ga.y); o.y = pk2(b[8 * j + 2] * rs * ga.z, b[8 * j + 3] * rs * ga.w);
                o.z = pk2(b[8 * j + 4] * rs * gc.x, b[8 * j + 5] * rs * gc.y); o.w = pk2(b[8 * j + 6] * rs * gc.z, b[8 * j + 7] * rs * gc.w); dst[j] = o; }
        }
        GRID_BAR();
    }

    if (IN(4)) {
        pg8::Gemm g{HN, Wout_t, MTOK, DM, DM}; pg8::StaticOrder S; S.init(MTOK, DM, G, (int)blockIdx.x);
        pg8::EpiResNorm E{args.in[I_XP], args.in[I_XS], MPROMPT / 256, OUT, DM, H2, args.in[I_NXG], SSQ1};
        pg8::gemm_phase<pg8::EpiResNorm, pg8::StaticOrder, true, true>(lds + RING_OFF, g, S, E);
        GRID_BAR();
    }
    if (IN(6)) {
        pg8::Gemm g{H2, Wxq_t, MTOK, XW, DM}; pg8::StaticOrder S; S.init(MTOK, XW, G, (int)blockIdx.x);
        pg8::EpiBf16S E{QX, XW, QSCALE, SSQ1};
        pg8::gemm_phase<pg8::EpiBf16S, pg8::StaticOrder, true, true>(lds + RING_OFF, g, S, E);
        GRID_BAR();
    }
    if (IN(7)) {
        LAS unsigned char* img = lds + wave * (32 * IMG_PITCH);
        const int c = lane & 31, hi = lane >> 5;
        constexpr int NITEM = XHEADS * (MTOK / 32);
        const int ipw = (NITEM + NGW - 1) / NGW; const int it0 = gw * ipw, it1 = (it0 + ipw < NITEM) ? it0 + ipw : NITEM;
        for (int it = it0; it < it1; ++it) {
            const int xh = it / 1024, tbk = it % 1024, R = 32 * tbk;
            const int mrow0 = (R < MPROMPT) ? 0 : 256 + 256 * ((R - MPROMPT) / SEQ_S);
            bf16x8 qf[8];
            { const bf16* qp = QX + (size_t)(R + c) * XW + xh * HD + 8 * hi;
#pragma unroll
              for (int ks = 0; ks < 8; ++ks) qf[ks] = *(const GAS bf16x8*)(qp + 16 * ks); }
            f32x16 o[4];
#pragma unroll
            for (int dd = 0; dd < 4; ++dd)
#pragma unroll
                for (int i = 0; i < 16; ++i) o[dd][i] = 0.f;
            float m = -1e30f, l = 0.f;
            for (int kt = 0; kt < 8; ++kt) {
                const bf16* kp = KVX + (size_t)(mrow0 + 32 * kt + c) * (2 * XW) + xh * HD + 8 * hi;
                const bf16* vp = KVX + (size_t)(mrow0 + 32 * kt + (lane >> 4)) * (2 * XW) + XW + xh * HD + 8 * (lane & 15);
                attn_tile<false>(o, m, l, qf, kp, vp, (size_t)4 * 2 * XW, img, 0.f, lane, 0);
            }
            attn_store(o, l, OX + (size_t)(R + c) * XW + xh * HD, hi);
        }
        GRID_BAR();
    }
    if (IN(8)) {
        pg8::Gemm g{OX, Wxo_t, MTOK, DM, XW}; pg8::StaticOrder S; S.init(MTOK, DM, G, (int)blockIdx.x);
        pg8::EpiResNorm E{OUT, OUT, 1 << 30, OUT, DM, HN, args.in[I_NFFNG], SSQ2};
        pg8::gemm_phase<pg8::EpiResNorm, pg8::StaticOrder, true, true>(lds + RING_OFF, g, S, E);
        GRID_BAR();
    }
    if (IN(10)) {
        const float* cw = args.in[I_CONVW]; const float* cb = args.in[I_CONVB];
#pragma unroll
        for (int ch = 0; ch < 4; ++ch) {
            const int p_lo = 32 * ch - (ch == 1 ? 1 : 0), np = 32 + (ch < 2 ? 1 : 0), zrow0 = p_lo * 256, r0 = 8192 * ch;
            { pg8::Gemm g{HN + (size_t)zrow0 * DM, Wup_t, np * 256, 2 * DFF, DM}; pg8::StaticOrder S; S.init(np * 256, 2 * DFF, G, (int)blockIdx.x);
              pg8::EpiBf16S E{ZB, 2 * DFF, 1.0f, SSQ2 + zrow0};
              pg8::gemm_phase<pg8::EpiBf16S, pg8::StaticOrder, true, true>(lds + RING_OFF, g, S, E); }
            GRID_BAR();
            { constexpr int NCC = DFF / 8, NRB = 8192 / 16;
              for (int item = blockIdx.x * 512 + tid; item < NCC * NRB; item += G * 512) {
                  const int cc = item % NCC, rb = item / NCC, col = 8 * cc, t0 = r0 + 16 * rb;
                  float wg[3][8], wv[3][8], bg[8], bvv[8];
#pragma unroll
                  for (int k = 0; k < 3; ++k)
#pragma unroll
                      for (int j = 0; j < 8; ++j) { wg[k][j] = cw[k * (2 * DFF) + col + j]; wv[k][j] = cw[k * (2 * DFF) + DFF + col + j]; }
#pragma unroll
                  for (int j = 0; j < 8; ++j) { bg[j] = cb[col + j]; bvv[j] = cb[DFF + col + j]; }
                  const bf16* zbase = ZB + (size_t)(t0 - zrow0) * (2 * DFF) + col;
                  v4u gp, gc, gn, vp, vc, vn;
                  const bool first_has_prev = (t0 < MPROMPT) ? (t0 != 0) : ((t0 & (SEQ_S - 1)) != 0);
                  if (first_has_prev) { gp = *(const GAS v4u*)(zbase - (size_t)(2 * DFF)); vp = *(const GAS v4u*)(zbase - (size_t)(2 * DFF) + DFF); } else { gp = (v4u){0u, 0u, 0u, 0u}; vp = gp; }
                  gc = *(const GAS v4u*)(zbase); vc = *(const GAS v4u*)(zbase + DFF);
                  for (int rr = 0; rr < 16; ++rr) { const int t = t0 + rr;
                      const bool has_next = (t < MPROMPT) ? (t != MPROMPT - 1) : ((t & (SEQ_S - 1)) != SEQ_S - 1);
                      if (has_next) { gn = *(const GAS v4u*)(zbase + (size_t)(rr + 1) * (2 * DFF)); vn = *(const GAS v4u*)(zbase + (size_t)(rr + 1) * (2 * DFF) + DFF); } else { gn = (v4u){0u, 0u, 0u, 0u}; vn = gn; }
                      float og[8];
#define CG(j, P, C, N, VP, VC, VN, SEL) { const float zg = SEL(P) * wg[0][j] + SEL(C) * wg[1][j] + SEL(N) * wg[2][j] + bg[j]; const float zv = SEL(VP) * wv[0][j] + SEL(VC) * wv[1][j] + SEL(VN) * wv[2][j] + bvv[j]; \
                          og[j] = zg * __builtin_amdgcn_rcpf(1.0f + __builtin_amdgcn_exp2f(-LOG2E * zg)) * zv; }
                      CG(0, gp.x, gc.x, gn.x, vp.x, vc.x, vn.x, bflo) CG(1, gp.x, gc.x, gn.x, vp.x, vc.x, vn.x, bfhi)
                      CG(2, gp.y, gc.y, gn.y, vp.y, vc.y, vn.y, bflo) CG(3, gp.y, gc.y, gn.y, vp.y, vc.y, vn.y, bfhi)
                      CG(4, gp.z, gc.z, gn.z, vp.z, vc.z, vn.z, bflo) CG(5, gp.z, gc.z, gn.z, vp.z, vc.z, vn.z, bfhi)
                      CG(6, gp.w, gc.w, gn.w, vp.w, vc.w, vn.w, bflo) CG(7, gp.w, gc.w, gn.w, vp.w, vc.w, vn.w, bfhi)
#undef CG
                      v4u o; o.x = pk2(og[0], og[1]); o.y = pk2(og[2], og[3]); o.z = pk2(og[4], og[5]); o.w = pk2(og[6], og[7]);
                      *(GAS v4u*)(GB + (size_t)(t - r0) * DFF + col) = o;
                      gp = gc; gc = gn; vp = vc; vc = vn; }
              } }
            GRID_BAR();
            { pg8::Gemm g{GB, Wdn_t, 8192, DM, DFF}; pg8::StaticOrder S; S.init(8192, DM, G, (int)blockIdx.x);
              float* ob = OUT + (size_t)r0 * DM;
              pg8::EpiResNorm E{ob, ob, 1 << 30, ob, DM, nullptr, nullptr, SSQ3 + r0};
              pg8::gemm_phase<pg8::EpiResNorm, pg8::StaticOrder, true, true>(lds + RING_OFF, g, S, E); }
            GRID_BAR();
        }
    }
    if (IN(11)) {
        const GAS f32x4* gp = (const GAS f32x4*)args.in[I_FING]; GAS f32x4* op = (GAS f32x4*)OUT;
        const int nth = G * 512;
        for (int i0 = blockIdx.x * 512 + tid; i0 < MTOK * (DM / 4); i0 += 4 * nth) {
            f32x4 v[4];
#pragma unroll
            for (int k = 0; k < 4; ++k) v[k] = op[i0 + k * nth];
#pragma unroll
            for (int k = 0; k < 4; ++k) { const int i = i0 + k * nth; const float rs = __builtin_amdgcn_rsqf(SSQ3[i >> 10] * (1.0f / DM) + EPS); op[i] = v[k] * rs * gp[i & 1023]; }
        }
    }
#undef IN
#undef GRID_BAR
}

extern "C" void kernel_launch(void* const* d_in, const int* in_sizes, int n_in, void* d_out, int out_size, void* d_ws, size_t ws_size, hipStream_t stream) {
    static int grid = 0;
    if (grid == 0) {
        if (n_in != 24 || out_size != MTOK * DM || ws_size < WS_END) { fprintf(stderr, "kernel_launch: unexpected shapes (n_in %d, out %d, ws %zu)\n", n_in, out_size, ws_size); grid = -1; return; }
        int dev = 0, cus = 0, per_cu = 0;
        if (hipGetDevice(&dev) != hipSuccess || hipDeviceGetAttribute(&cus, hipDeviceAttributeMultiprocessorCount, dev) != hipSuccess) { grid = -1; return; }
        if (hipFuncSetAttribute((const void*)fwd_kernel, hipFuncAttributeMaxDynamicSharedMemorySize, LDS_BYTES) != hipSuccess) { fprintf(stderr, "kernel_launch: hipFuncSetAttribute failed\n"); grid = -1; return; }
        if (hipOccupancyMaxActiveBlocksPerMultiprocessor(&per_cu, (const void*)fwd_kernel, NWAVES * 64, LDS_BYTES) != hipSuccess || per_cu < 1) { fprintf(stderr, "kernel_launch: occupancy query reports %d\n", per_cu); }
        (void)hipGetLastError();
        grid = cus;
    }
    if (grid < 0) return;
    if (hipMemsetAsync((char*)d_ws + WS_CTL, 0, CTL_ZERO_BYTES, stream) != hipSuccess) { fprintf(stderr, "kernel_launch: memset failed\n"); return; }
    Args a{};
    for (int i = 0; i < 24; ++i) a.in[i] = (const float*)d_in[i];
    a.out = (float*)d_out; a.ws = (unsigned char*)d_ws; a.ph_lo = 0; a.ph_hi = 12;
    hipLaunchKernelGGL(fwd_kernel, dim3(grid), dim3(NWAVES * 64), LDS_BYTES, stream, a);
    const hipError_t le = hipPeekAtLastError();
    if (le != hipSuccess) fprintf(stderr, "kernel_launch: launch failed: %s\n", hipGetErrorName(le));
}
```

```cpp
#include <hip/hip_runtime.h>
#include <cstdio>
#include <cstdint>
namespace pg8 {
#define PG8_LAS __attribute__((address_space(3)))
typedef unsigned short bf16_t;
typedef short bf16x8 __attribute__((ext_vector_type(8)));
typedef float f32x4 __attribute__((ext_vector_type(4)));
typedef unsigned u32x4 __attribute__((ext_vector_type(4)));
constexpr int BM = 256, BK = 64, HALF = 128, HTB = HALF * BK * 2  , STAGE_BYTES = 8 * HTB, NXCD = 8, WGM = 8;

__host__ __device__ __forceinline__ int lds_byte(int r, int c) { const int st = (r >> 4) * 2 + (c >> 5), rr = r & 15, cc = c & 31, ob = rr * 64 + cc * 2; return st * 1024 + (ob ^ (((ob >> 9) & 1) << 5)); }
__host__ __device__ __forceinline__ void stage_rc(int b, int& R, int& C) { const int st = b / 1024, sb = b % 1024, swz = sb ^ (((sb >> 9) & 1) << 5); R = (st >> 1) * 16 + swz / 64; C = (st & 1) * 32 + (swz % 64) / 2; }
__host__ __device__ __forceinline__ int perm32(int rho) { const int n = rho >> 4, i = rho & 15; return 8 * (i >> 2) + 4 * n + (i & 3); }

struct Unit { int pm, pn; };
struct Gemm { const bf16_t* A; const bf16_t* Bt; int M, N, K; };

struct StaticOrder {
    int nM, nN, nwg, G, c;
    __host__ __device__ void init(int M, int N, int G_, int c_) { nM = M / BM; nN = N / BM; nwg = nM * nN; G = G_; c = c_; }
    __host__ __device__ bool next(int i, Unit& u) const {
        const long L = (long)i * G + c; if (L >= nwg) return false;
        int wgid = (int)L; { const int q = nwg / NXCD, r = nwg % NXCD, xcd = wgid % NXCD, off = wgid / NXCD; wgid = (xcd < r ? xcd * (q + 1) : r * (q + 1) + (xcd - r) * q) + off; }
        const int nig = WGM * nN, gid = wgid / nig, fm = gid * WGM, gsz = (nM - fm) < WGM ? (nM - fm) : WGM;
        u.pm = fm + ((wgid % nig) % gsz); u.pn = (wgid % nig) / gsz; return true;
    }
    __device__ __forceinline__ void a_ready(const Unit&) const {}
    __device__ __forceinline__ void done(const Unit&) const {}
};

typedef float f32x2 __attribute__((ext_vector_type(2)));
typedef __bf16 bf16x2v __attribute__((ext_vector_type(2)));
__device__ __forceinline__ unsigned cvt_pk_bf16(float lo, float hi) { const f32x2 v = {lo, hi}; return __builtin_bit_cast(unsigned, __builtin_convertvector(v, bf16x2v)); }
__device__ __forceinline__ float gelu_tanh(float x) {
    const float t = x * (1.0f + 0.044715f * x * x) * (-2.3022082f);
    return x * __builtin_amdgcn_rcpf(1.0f + __builtin_amdgcn_exp2f(t));
}
struct EpiInProj {
    static constexpr bool PERM = true, AFTER_DRAIN = false;
    bf16_t* O; int ldc; float qscale;
    __device__ __forceinline__ void operator()(const f32x4 (&acc)[2][2][4][2], const Unit& u, int wr, int wc, int fr, int fq) const {
        const int row0 = u.pm * BM + wr * 64 + fr, col0 = u.pn * BM + wc * 32 + 8 * fq;
        const bool do_gelu = u.pn < 16; const float sc = (u.pn >= 16 && u.pn < 24) ? qscale : 1.0f;
#pragma unroll
        for (int ai = 0; ai < 2; ++ai)
#pragma unroll
            for (int m = 0; m < 4; ++m) { bf16_t* rowp = O + (size_t)(row0 + ai * HALF + m * 16) * ldc + col0;
#pragma unroll
                for (int bj = 0; bj < 2; ++bj) { f32x4 v0 = acc[ai][bj][m][0], v1 = acc[ai][bj][m][1];
                    if (do_gelu) {
#pragma unroll
                        for (int j = 0; j < 4; ++j) { v0[j] = gelu_tanh(v0[j]); v1[j] = gelu_tanh(v1[j]); } }
                    else { v0 = v0 * sc; v1 = v1 * sc; }
                    u32x4 w; w.x = cvt_pk_bf16(v0[0], v0[1]); w.y = cvt_pk_bf16(v0[2], v0[3]); w.z = cvt_pk_bf16(v1[0], v1[1]); w.w = cvt_pk_bf16(v1[2], v1[3]);
                    *(u32x4*)(rowp + bj * HALF) = w; } }
    }
};
struct EpiBf16S {
    static constexpr bool PERM = true, AFTER_DRAIN = false;
    bf16_t* O; int ldc; float scale0; const float* ssq;
    __device__ __forceinline__ void operator()(const f32x4 (&acc)[2][2][4][2], const Unit& u, int wr, int wc, int fr, int fq) const {
        const int row0 = u.pm * BM + wr * 64 + fr, col0 = u.pn * BM + wc * 32 + 8 * fq;
#pragma unroll
        for (int ai = 0; ai < 2; ++ai)
#pragma unroll
            for (int m = 0; m < 4; ++m) { bf16_t* rowp = O + (size_t)(row0 + ai * HALF + m * 16) * ldc + col0;
                const float scale = ssq ? scale0 * __builtin_amdgcn_rsqf(ssq[row0 + ai * HALF + m * 16] * (1.0f / 4096.0f) + 1e-6f) : scale0;
#pragma unroll
                for (int bj = 0; bj < 2; ++bj) { const f32x4 v0 = acc[ai][bj][m][0] * scale, v1 = acc[ai][bj][m][1] * scale;
                    u32x4 w; w.x = cvt_pk_bf16(v0[0], v0[1]); w.y = cvt_pk_bf16(v0[2], v0[3]); w.z = cvt_pk_bf16(v1[0], v1[1]); w.w = cvt_pk_bf16(v1[2], v1[3]);
                    *(u32x4*)(rowp + bj * HALF) = w; } }
    }
};
struct EpiResF32 {
    static constexpr bool PERM = false, AFTER_DRAIN = false;
    const float* base0; const float* base1; int split_pm; float* out; int ldc;
    __device__ __forceinline__ void operator()(const f32x4 (&acc)[2][2][4][2], const Unit& u, int wr, int wc, int fr, int fq) const {
        const int rowl = wr * 64 + fr, col0 = u.pn * BM + wc * 32 + 4 * fq;
        const float* bp = (u.pm < split_pm) ? base0 + (size_t)u.pm * BM * ldc : base1 + (size_t)(u.pm - split_pm) * BM * ldc;
        float* op = out + (size_t)u.pm * BM * ldc;
#pragma unroll
        for (int ai = 0; ai < 2; ++ai)
#pragma unroll
            for (int m = 0; m < 4; ++m) { const size_t off = (size_t)(rowl + ai * HALF + m * 16) * ldc + col0;
#pragma unroll
                for (int bj = 0; bj < 2; ++bj)
#pragma unroll
                    for (int n = 0; n < 2; ++n) { const f32x4 b = *(const f32x4*)(bp + off + bj * HALF + n * 16); *(f32x4*)(op + off + bj * HALF + n * 16) = b + acc[ai][bj][m][n]; } }
    }
};

struct EpiResNorm {
    static constexpr bool PERM = true, AFTER_DRAIN = false;
    const float* base0; const float* base1; int split_pm; float* out; int ldc; bf16_t* hn; const float* g; float* ssq;
    __device__ __forceinline__ void operator()(const f32x4 (&acc)[2][2][4][2], const Unit& u, int wr, int wc, int fr_, int fq_) const {
        int fr = fr_, fq = fq_; asm volatile("" : "+v"(fr), "+v"(fq));
        const int rowl = wr * 64 + fr, col0 = u.pn * BM + wc * 32 + 8 * fq;
        const float* bp = (u.pm < split_pm) ? base0 + (size_t)u.pm * BM * ldc : base1 + (size_t)(u.pm - split_pm) * BM * ldc;
        float* op = out + (size_t)u.pm * BM * ldc;
        f32x4 gv[2][2];
#pragma unroll
        for (int bj = 0; bj < 2; ++bj)
#pragma unroll
            for (int n = 0; n < 2; ++n) gv[bj][n] = hn ? *(const f32x4*)(g + col0 + bj * HALF + 4 * n) : (f32x4){0.f, 0.f, 0.f, 0.f};
#pragma unroll
        for (int ai = 0; ai < 2; ++ai)
#pragma unroll
            for (int m = 0; m < 4; ++m) { const int r = rowl + ai * HALF + m * 16; const size_t off = (size_t)r * ldc + col0; float sq = 0.f;
#pragma unroll
                for (int bj = 0; bj < 2; ++bj) {
                    const f32x4 x0 = *(const f32x4*)(bp + off + bj * HALF) + acc[ai][bj][m][0], x1 = *(const f32x4*)(bp + off + bj * HALF + 4) + acc[ai][bj][m][1];
                    *(f32x4*)(op + off + bj * HALF) = x0; *(f32x4*)(op + off + bj * HALF + 4) = x1;
                    sq += (x0[0] * x0[0] + x0[1] * x0[1]) + (x0[2] * x0[2] + x0[3] * x0[3]) + (x1[0] * x1[0] + x1[1] * x1[1]) + (x1[2] * x1[2] + x1[3] * x1[3]);
                    if (hn) { const f32x4 h0 = x0 * gv[bj][0], h1 = x1 * gv[bj][1];
                        u32x4 w; w.x = cvt_pk_bf16(h0[0], h0[1]); w.y = cvt_pk_bf16(h0[2], h0[3]); w.z = cvt_pk_bf16(h1[0], h1[1]); w.w = cvt_pk_bf16(h1[2], h1[3]);
                        *(u32x4*)(hn + (size_t)u.pm * BM * ldc + off + bj * HALF) = w; } }
                sq += __shfl_xor(sq, 16); sq += __shfl_xor(sq, 32);
                if (fq == 0) __hip_atomic_fetch_add(ssq + (size_t)u.pm * BM + r, sq, __ATOMIC_RELAXED, __HIP_MEMORY_SCOPE_AGENT);
                asm volatile("" ::: "memory"); }
    }
};

__device__ __forceinline__ float dpp_ror1(float x) { return __builtin_bit_cast(float, __builtin_amdgcn_update_dpp(0, __builtin_bit_cast(int, x), 0x121, 0xf, 0xf, false)); }
__device__ __forceinline__ float dpp_rol1(float x) { return __builtin_bit_cast(float, __builtin_amdgcn_update_dpp(0, __builtin_bit_cast(int, x), 0x12f, 0xf, 0xf, false)); }
__device__ __forceinline__ unsigned dpp_ror1u(unsigned x) { return (unsigned)__builtin_amdgcn_update_dpp(0, (int)x, 0x121, 0xf, 0xf, false); }
__device__ __forceinline__ unsigned dpp_rol1u(unsigned x) { return (unsigned)__builtin_amdgcn_update_dpp(0, (int)x, 0x12f, 0xf, 0xf, false); }
__device__ __forceinline__ float bfsel(unsigned w, int h) { return __uint_as_float(h ? (w & 0xffff0000u) : (w << 16)); }
struct EpiConvGate {
    static constexpr bool PERM = true, AFTER_DRAIN = false;
    bf16_t* Gout; const float* ssq; const float* cw; const float* cb; float* edge; PG8_LAS float* xch; int dff;
    __device__ __forceinline__ void operator()(const f32x4 (&acc_)[2][2][4][2], const Unit& u, int wr, int wc, int fr_, int fq_) const {
        const f32x4 (&acc)[2][2][4][2] = acc_;
        int fr = fr_, fq = fq_; asm volatile("" : "+v"(fr), "+v"(fq));
        const int wave = wr * 4 + wc, lc = 32 * wc + 8 * fq, cg = u.pn * HALF + lc, cv = dff + cg;
        const int ldw = 2 * dff;
        const bool f0 = (fr == 0), f15 = (fr == 15);
        PG8_LAS float* my = xch + wave * 256 + fq * 16;
        const unsigned rowb = (unsigned)(u.pm * BM + wr * 64 + fr);
        unsigned zp[2][2][4][2][2];
#pragma unroll
        for (int ai = 0; ai < 2; ++ai)
#pragma unroll
            for (int m = 0; m < 4; ++m) {
                const float rs = __builtin_amdgcn_rsqf(ssq[rowb + (unsigned)(ai * HALF + m * 16)] * (1.0f / 4096.0f) + 1e-6f);
                f32x4 z[2][2];
#pragma unroll
                for (int bj = 0; bj < 2; ++bj)
#pragma unroll
                    for (int n = 0; n < 2; ++n) z[bj][n] = acc[ai][bj][m][n] * rs;
                if (m == 0 && f0) {
#pragma unroll
                    for (int bj = 0; bj < 2; ++bj)
#pragma unroll
                        for (int n = 0; n < 2; ++n) *(PG8_LAS f32x4*)(my + (ai * 2 + 0) * 64 + (bj * 2 + n) * 4) = z[bj][n]; }
                if (m == 3 && f15) {
#pragma unroll
                    for (int bj = 0; bj < 2; ++bj)
#pragma unroll
                        for (int n = 0; n < 2; ++n) *(PG8_LAS f32x4*)(my + (ai * 2 + 1) * 64 + (bj * 2 + n) * 4) = z[bj][n]; }
                if (ai == 0 && m == 0 && wr == 0 && fr < 2) { float* ep = edge + ((size_t)u.pm * 4 + fr) * ldw;
#pragma unroll
                    for (int n = 0; n < 2; ++n) { *(f32x4*)(ep + cg + 4 * n) = z[0][n]; *(f32x4*)(ep + cv + 4 * n) = z[1][n]; } }
                if (ai == 1 && m == 3 && wr == 1 && fr >= 14) { float* ep = edge + ((size_t)u.pm * 4 + (fr - 12)) * ldw;
#pragma unroll
                    for (int n = 0; n < 2; ++n) { *(f32x4*)(ep + cg + 4 * n) = z[0][n]; *(f32x4*)(ep + cv + 4 * n) = z[1][n]; } }
#pragma unroll
                for (int bj = 0; bj < 2; ++bj)
#pragma unroll
                    for (int n = 0; n < 2; ++n) { zp[ai][bj][m][n][0] = cvt_pk_bf16(z[bj][n][0], z[bj][n][1]); zp[ai][bj][m][n][1] = cvt_pk_bf16(z[bj][n][2], z[bj][n][3]); }
                asm volatile("" : "+v"(zp[ai][0][m][0][0]), "+v"(zp[ai][0][m][0][1]), "+v"(zp[ai][0][m][1][0]), "+v"(zp[ai][0][m][1][1]), "+v"(zp[ai][1][m][0][0]), "+v"(zp[ai][1][m][0][1]), "+v"(zp[ai][1][m][1][0]), "+v"(zp[ai][1][m][1][1]));
            }
        asm volatile("s_waitcnt lgkmcnt(0)" ::: "memory"); __builtin_amdgcn_s_barrier(); asm volatile("" ::: "memory");
#pragma unroll
        for (int n = 0; n < 2; ++n) {
#pragma unroll
            for (int ai = 0; ai < 2; ++ai) {
                asm volatile("" ::: "memory");
                f32x4 w0[2], w1[2], w2[2], bb[2], T[2], B[2];
                int tw = -1, tai = 0, bw = -1, bai = 0;
                if (wr == 1) { tw = wc; tai = ai; } else if (ai == 1) { tw = 4 + wc; tai = 0; }
                if (wr == 0) { bw = 4 + wc; bai = ai; } else if (ai == 0) { bw = wc; bai = 1; }
#pragma unroll
                for (int bj = 0; bj < 2; ++bj) { const int c = (bj ? cv : cg) + 4 * n;
                    w0[bj] = *(const f32x4*)(cw + c); w1[bj] = *(const f32x4*)(cw + ldw + c); w2[bj] = *(const f32x4*)(cw + 2 * ldw + c); bb[bj] = *(const f32x4*)(cb + c);
                    T[bj] = (tw >= 0) ? *(const PG8_LAS f32x4*)(xch + tw * 256 + fq * 16 + (tai * 2 + 1) * 64 + (bj * 2 + n) * 4) : (f32x4){0.f, 0.f, 0.f, 0.f};
                    B[bj] = (bw >= 0) ? *(const PG8_LAS f32x4*)(xch + bw * 256 + fq * 16 + (bai * 2 + 0) * 64 + (bj * 2 + n) * 4) : (f32x4){0.f, 0.f, 0.f, 0.f}; }
                unsigned gpk[4][2];
#pragma unroll
                for (int jp = 0; jp < 2; ++jp) {
                    float zc[2][2][4];
#pragma unroll
                    for (int bj = 0; bj < 2; ++bj) {
                        unsigned rw[4], lw[4];
#pragma unroll
                        for (int m = 0; m < 4; ++m) { rw[m] = dpp_ror1u(zp[ai][bj][m][n][jp]); lw[m] = dpp_rol1u(zp[ai][bj][m][n][jp]); }
#pragma unroll
                        for (int h = 0; h < 2; ++h) { const int j = 2 * jp + h;
                            const float w0a = f0 ? 0.f : w0[bj][j], w0b = f0 ? w0[bj][j] : 0.f, w2a = f15 ? 0.f : w2[bj][j], w2b = f15 ? w2[bj][j] : 0.f;
#pragma unroll
                            for (int m = 0; m < 4; ++m) { const float v = bfsel(zp[ai][bj][m][n][jp], h), r = bfsel(rw[m], h), l = bfsel(lw[m], h);
                                const float P = (m == 0) ? T[bj][j] : bfsel(rw[m - 1], h), N = (m == 3) ? B[bj][j] : bfsel(lw[m + 1], h);
                                zc[bj][h][m] = bb[bj][j] + w1[bj][j] * v + w0a * r + w0b * P + w2a * l + w2b * N; } }
                    }
#pragma unroll
                    for (int m = 0; m < 4; ++m) { float gv[2];
#pragma unroll
                        for (int h = 0; h < 2; ++h) { const float zg = zc[0][h][m]; gv[h] = zg * __builtin_amdgcn_rcpf(1.0f + __builtin_amdgcn_exp2f(-1.4426950408889634f * zg)) * zc[1][h][m]; }
                        gpk[m][jp] = cvt_pk_bf16(gv[0], gv[1]); }
                }
#pragma unroll
                for (int m = 0; m < 4; ++m) { const int R = ai * HALF + wr * 64 + m * 16 + fr;
                    if (R != 0 && R != BM - 1) { typedef unsigned u32x2v __attribute__((ext_vector_type(2))); u32x2v w; w.x = gpk[m][0]; w.y = gpk[m][1];
                        *(u32x2v*)(Gout + (size_t)(u.pm * BM + R) * dff + cg + 4 * n) = w; } }
            }
        }
    }
};

template <class Epi, class Sched, bool ALIGN_EPI = false, bool SP2 = false>
__device__ __forceinline__ void gemm_phase(PG8_LAS unsigned char* lds, const Gemm g, const Sched& S, const Epi& E) {
    int tid_ = threadIdx.x; asm volatile("" : "+v"(tid_));
    const int tid = tid_, wid = __builtin_amdgcn_readfirstlane(tid >> 6), lane = tid & 63, wr = wid >> 2, wc = wid & 3, fr = lane & 15, fq = lane >> 4;
    const int K = g.K, nt = K / BK;
    unsigned voffA[2], voffB[2];
#pragma unroll
    for (int i = 0; i < 2; ++i) { int R, C; stage_rc(tid * 16 + i * 8192, R, C); const int Rb = Epi::PERM ? ((R & ~31) + perm32(R & 31)) : R;
        voffA[i] = (unsigned)(R * K + C) * 2u; voffB[i] = (unsigned)(Rb * K + C) * 2u; }
    const size_t kstep = (size_t)(BK * 2);
    const size_t hstep = (size_t)HALF * K * 2;
    const size_t tstep = 2 * hstep;
    const unsigned ldsw = (unsigned)wid * 1024u;
    const int aoff = lds_byte(wr * 64 + fr, fq * 8), boff = lds_byte(wc * 32 + fr, fq * 8);
#define PG8_SA(b, h) (((b) * 2 + (h)) * HTB)
#define PG8_SB(b, h) ((4 + (b) * 2 + (h)) * HTB)
#define PG8_STAGE(bufoff, gbase, voff) do { _Pragma("unroll") for (int _i = 0; _i < 2; ++_i) \
        __builtin_amdgcn_global_load_lds((const unsigned*)((const char*)(gbase) + (voff)[_i]), (PG8_LAS unsigned*)(lds + (bufoff) + ldsw + _i * 8192), 16, 0, 0); } while (0)
#define PG8_LDA(dst, b, h) do { _Pragma("unroll") for (int m = 0; m < 4; ++m) _Pragma("unroll") for (int k = 0; k < 2; ++k) dst[m][k] = *(const PG8_LAS bf16x8*)(lds + PG8_SA(b, h) + aoff + m * 2048 + k * 1024); } while (0)
#define PG8_LDB(dst, b, h) do { _Pragma("unroll") for (int n = 0; n < 2; ++n) _Pragma("unroll") for (int k = 0; k < 2; ++k) dst[n][k] = *(const PG8_LAS bf16x8*)(lds + PG8_SB(b, h) + boff + n * 2048 + k * 1024); } while (0)
#define PG8_MMA(ai, bj, At, Bt) do { __builtin_amdgcn_s_setprio(1); _Pragma("unroll") for (int m = 0; m < 4; ++m) _Pragma("unroll") for (int n = 0; n < 2; ++n) _Pragma("unroll") for (int k = 0; k < 2; ++k) \
        acc[ai][bj][m][n] = __builtin_amdgcn_mfma_f32_16x16x32_bf16(Bt[n][k], At[m][k], acc[ai][bj][m][n], 0, 0, 0); __builtin_amdgcn_s_setprio(0); } while (0)
#define PG8_WAIT_V(n) asm volatile("s_waitcnt vmcnt(" #n ")" ::: "memory")
#define PG8_WAIT_L(n) asm volatile("s_waitcnt lgkmcnt(" #n ")" ::: "memory")
#define PG8_BAR __builtin_amdgcn_s_barrier()
#define PG8_SCHED __builtin_amdgcn_sched_barrier(0)
    Unit cur, nxt; int ui = 0;
    if (!S.next(0, cur)) return;
    f32x4 acc[2][2][4][2];
#pragma unroll
    for (int a = 0; a < 2; ++a)
#pragma unroll
        for (int b = 0; b < 2; ++b)
#pragma unroll
            for (int m = 0; m < 4; ++m)
#pragma unroll
                for (int n = 0; n < 2; ++n) acc[a][b][m][n] = (f32x4){0.f, 0.f, 0.f, 0.f};
    bf16x8 At[4][2], B0[2][2], B1[2][2];
    const char* cA = (const char*)g.A + (size_t)cur.pm * tstep; const char* cB = (const char*)g.Bt + (size_t)cur.pn * tstep;
    S.a_ready(cur);
    if constexpr (SP2) {
        PG8_STAGE(PG8_SB(0, 0), cB, voffB); PG8_STAGE(PG8_SB(0, 1), cB + hstep, voffB); PG8_STAGE(PG8_SA(0, 0), cA, voffA); PG8_STAGE(PG8_SA(0, 1), cA + hstep, voffA);
        if (wr == 1) PG8_BAR;
        PG8_WAIT_V(2); PG8_BAR;
        PG8_STAGE(PG8_SB(1, 0), cB + kstep, voffB); PG8_STAGE(PG8_SA(1, 0), cA + kstep, voffA); PG8_STAGE(PG8_SB(1, 1), cB + hstep + kstep, voffB);
        PG8_WAIT_V(6); PG8_BAR;
    } else {
        PG8_STAGE(PG8_SB(0, 0), cB, voffB); PG8_STAGE(PG8_SA(0, 0), cA, voffA); PG8_STAGE(PG8_SB(0, 1), cB + hstep, voffB); PG8_STAGE(PG8_SA(0, 1), cA + hstep, voffA);
        if (wr == 1) PG8_BAR;
        PG8_WAIT_V(4); PG8_BAR;
        PG8_STAGE(PG8_SB(1, 0), cB + kstep, voffB); PG8_STAGE(PG8_SA(1, 0), cA + kstep, voffA); PG8_STAGE(PG8_SB(1, 1), cB + hstep + kstep, voffB);
        PG8_WAIT_V(6); PG8_BAR;
    }
    for (;;) {
        const bool has_next = S.next(ui + 1, nxt);
        const char* nA = has_next ? (const char*)g.A + (size_t)nxt.pm * tstep : cA; const char* nB = has_next ? (const char*)g.Bt + (size_t)nxt.pn * tstep : cB;
        for (int t = 0; t < nt; t += 2) {
            const bool last = (t == nt - 2);
            const char* a1 = cA + (size_t)(t + 1) * kstep;
            const char* a2 = last ? nA : cA + (size_t)(t + 2) * kstep; const char* b2 = last ? nB : cB + (size_t)(t + 2) * kstep;
            const char* a3 = a2 + kstep; const char* b3 = b2 + kstep;
            if (last && has_next) S.a_ready(nxt);
            if constexpr (SP2) {
            PG8_LDB(B0, 0, 0); PG8_LDB(B1, 0, 1); PG8_SCHED; PG8_LDA(At, 0, 0); PG8_STAGE(PG8_SA(1, 1), a1 + hstep, voffA);
            PG8_WAIT_V(8); PG8_WAIT_L(0); PG8_BAR; PG8_MMA(0, 0, At, B0); PG8_MMA(0, 1, At, B1); PG8_BAR; PG8_SCHED;
            PG8_LDA(At, 0, 1); PG8_STAGE(PG8_SB(0, 0), b2, voffB); PG8_STAGE(PG8_SB(0, 1), b2 + hstep, voffB); PG8_STAGE(PG8_SA(0, 0), a2, voffA);
            PG8_WAIT_V(8); PG8_WAIT_L(0); PG8_BAR; PG8_MMA(1, 0, At, B0); PG8_MMA(1, 1, At, B1); PG8_BAR; PG8_SCHED;
            PG8_LDB(B0, 1, 0); PG8_LDB(B1, 1, 1); PG8_SCHED; PG8_LDA(At, 1, 0); PG8_STAGE(PG8_SA(0, 1), a2 + hstep, voffA);
            PG8_WAIT_V(8); PG8_WAIT_L(0); PG8_BAR; PG8_MMA(0, 0, At, B0); PG8_MMA(0, 1, At, B1); PG8_BAR; PG8_SCHED;
            PG8_LDA(At, 1, 1); PG8_STAGE(PG8_SB(1, 0), b3, voffB); PG8_STAGE(PG8_SB(1, 1), b3 + hstep, voffB); PG8_STAGE(PG8_SA(1, 0), a3, voffA);
            PG8_WAIT_V(8); PG8_WAIT_L(0); PG8_BAR; PG8_MMA(1, 0, At, B0); PG8_MMA(1, 1, At, B1); PG8_BAR; PG8_SCHED;
            } else {
            PG8_LDB(B0, 0, 0); PG8_SCHED; PG8_LDA(At, 0, 0); PG8_STAGE(PG8_SA(1, 1), a1 + hstep, voffA);
            PG8_WAIT_L(8); PG8_BAR; PG8_WAIT_L(0); PG8_MMA(0, 0, At, B0); PG8_BAR; PG8_SCHED;
            PG8_LDB(B1, 0, 1); PG8_STAGE(PG8_SB(0, 0), b2, voffB);
            PG8_BAR; PG8_WAIT_L(0); PG8_MMA(0, 1, At, B1); PG8_BAR;
            PG8_LDA(At, 0, 1); PG8_STAGE(PG8_SA(0, 0), a2, voffA);
            PG8_BAR; PG8_WAIT_L(0); PG8_MMA(1, 0, At, B0); PG8_BAR; PG8_SCHED;
            PG8_STAGE(PG8_SB(0, 1), b2 + hstep, voffB);
            PG8_WAIT_V(6); PG8_BAR; PG8_MMA(1, 1, At, B1); PG8_BAR;
            PG8_LDB(B0, 1, 0); PG8_SCHED; PG8_LDA(At, 1, 0); PG8_STAGE(PG8_SA(0, 1), a2 + hstep, voffA);
            PG8_WAIT_L(8); PG8_BAR; PG8_WAIT_L(0); PG8_MMA(0, 0, At, B0); PG8_BAR; PG8_SCHED;
            PG8_LDB(B1, 1, 1); PG8_STAGE(PG8_SB(1, 0), b3, voffB);
            PG8_BAR; PG8_WAIT_L(0); PG8_MMA(0, 1, At, B1); PG8_BAR;
            PG8_LDA(At, 1, 1); PG8_STAGE(PG8_SA(1, 0), a3, voffA);
            PG8_BAR; PG8_WAIT_L(0); PG8_MMA(1, 0, At, B0); PG8_BAR; PG8_SCHED;
            PG8_STAGE(PG8_SB(1, 1), b3 + hstep, voffB);
            PG8_WAIT_V(6); PG8_BAR; PG8_MMA(1, 1, At, B1); PG8_BAR;
            }
        }
        if constexpr (ALIGN_EPI) { if (wr == 0) PG8_BAR; }
        if constexpr (!Epi::AFTER_DRAIN) { E(acc, cur, wr, wc, fr, fq); S.done(cur); }
        if (!has_next) break;
#pragma unroll
        for (int a = 0; a < 2; ++a)
#pragma unroll
            for (int b = 0; b < 2; ++b)
#pragma unroll
                for (int m = 0; m < 4; ++m)
#pragma unroll
                    for (int n = 0; n < 2; ++n) acc[a][b][m][n] = (f32x4){0.f, 0.f, 0.f, 0.f};
        cur = nxt; cA = nA; cB = nB; ++ui;
        if constexpr (ALIGN_EPI) { if (wr == 1) PG8_BAR; }
    }
    PG8_WAIT_V(0);
    if constexpr (!ALIGN_EPI) { if (wr == 0) PG8_BAR; }
    PG8_BAR;
    if constexpr (Epi::AFTER_DRAIN) { E.fused(acc, cur, wr, wc, fr, fq, lds, wid, lane); S.done(cur); }
#undef PG8_SA
#undef PG8_SB
#undef PG8_STAGE
#undef PG8_LDA
#undef PG8_LDB
#undef PG8_MMA
#undef PG8_WAIT_V
#undef PG8_WAIT_L
#undef PG8_BAR
#undef PG8_SCHED
}
}

constexpr int NWAVES = 8;
constexpr int DM = 4096, MTOK = 32768, MPROMPT = 16384, SEQ_S = 2048;
constexpr int HD = 128, NHEAD = 16, AWID = 2048, BWID = 2048, INW = 10240, NMEMROWS = 2304, XW = 512, XHEADS = 4, DFF = 11008;
constexpr int QOFF = 4096, KOFF = 6144, VOFF = 8192;
constexpr float EPS = 1e-6f;
constexpr float LOG2E = 1.4426950408889634f;
constexpr float QSCALE = 0.08838834764831845f * LOG2E;

constexpr size_t MiB = 1u << 20;
constexpr size_t WS_CTL = 0, CTL_ZERO_BYTES = 1 * MiB;
constexpr size_t WS_SGW = 1 * MiB;
constexpr size_t WS_WIN = 2 * MiB, WS_WOUT = 82 * MiB, WS_WXQ = 114 * MiB, WS_WXKV = 118 * MiB, WS_WXO = 126 * MiB, WS_WUP = 130 * MiB, WS_WDN = 302 * MiB;
constexpr size_t WS_HN = 388 * MiB;
constexpr size_t WS_PROJ = 644 * MiB;
constexpr size_t WS_MEMN = 1284 * MiB;
constexpr size_t WS_KVX = 1302 * MiB;
constexpr size_t WS_END = 1332 * MiB;
constexpr size_t PJ_QX = 0, PJ_OX = 32 * MiB, PJ_H2 = 64 * MiB;
constexpr size_t WS_EDGE = WS_WIN;
constexpr size_t OUT_OP = 0, OP_STRIDE = 128 * MiB, OUT_LSE = 384 * MiB;
constexpr int CW_BAR = 4096;
constexpr int CW_SSQ1 = 16384, CW_SSQ2 = CW_SSQ1 + MTOK, CW_SSQ3 = CW_SSQ2 + MTOK;
static_assert((CW_SSQ3 + MTOK) * 4 <= (int)CTL_ZERO_BYTES, "CTL words inside the memset region");

constexpr int RING_OFF = 0, RING_BYTES = 131072;
constexpr int LDSCTL_OFF = RING_BYTES, MISC_OFF = LDSCTL_OFF + 320;
constexpr int LDS_BYTES = 147456;
constexpr int XCH_OFF = 133120;
constexpr int IMG_PITCH = 320;

#define GAS __attribute__((address_space(1)))
#define LAS __attribute__((address_space(3)))
typedef unsigned short bf16;
typedef unsigned v4u __attribute__((ext_vector_type(4)));
typedef unsigned v2u __attribute__((ext_vector_type(2)));
typedef float f32x4 __attribute__((ext_vector_type(4)));
typedef float f32x16 __attribute__((ext_vector_type(16)));
typedef short bf16x8 __attribute__((ext_vector_type(8)));
typedef short s16x4 __attribute__((ext_vector_type(4)));
typedef GAS unsigned gu32;
#define RLX_AGENT __ATOMIC_RELAXED, __HIP_MEMORY_SCOPE_AGENT
#define LDS_WAIT() asm volatile("s_waitcnt lgkmcnt(0)" ::: "memory")
#define VM_WAIT() asm volatile("s_waitcnt vmcnt(0)" ::: "memory")
#define SBAR() __builtin_amdgcn_sched_barrier(0)
__device__ __forceinline__ unsigned pk2(float lo, float hi) { return pg8::cvt_pk_bf16(lo, hi); }
__device__ __forceinline__ float bflo(unsigned w) { return __uint_as_float(w << 16); }
__device__ __forceinline__ float bfhi(unsigned w) { return __uint_as_float(w & 0xffff0000u); }

#define XB_TMO      128
#define XB_XCNT(j)  (256  + 64 * (j))
#define XB_XSUB(j)  (1280 + 64 * (j))
#define XB_XGEN(j)  (2304 + 64 * (j))
#define XB_TOP      3328
#define XB_TOPGEN   3392
#define XCD_BAR_WORDS 3456
#define XB_SPIN_CAP (1u << 23)

__device__ __forceinline__ unsigned xb_ld(unsigned* p)              { return __hip_atomic_load(p, __ATOMIC_RELAXED, __HIP_MEMORY_SCOPE_AGENT); }
__device__ __forceinline__ unsigned xb_add(unsigned* p, unsigned v) { return __hip_atomic_fetch_add(p, v, __ATOMIC_RELAXED, __HIP_MEMORY_SCOPE_AGENT); }
__device__ __forceinline__ unsigned xb_xcc_id() { return (unsigned)__builtin_amdgcn_s_getreg((3 << 11) | 20) & 0xFu; }
#define XB_SPIN(cond, bar) do { unsigned _sp = 0; while (cond) { __builtin_amdgcn_s_sleep(1); \
    if ((++_sp & 255u) == 0u) { if (xb_ld(&(bar)[XB_TMO])) break; if (_sp > XB_SPIN_CAP) { atomicAdd(&(bar)[XB_TMO], 1u); break; } } } } while (0)

struct XcdBarrier { unsigned* bar; unsigned x; volatile LAS unsigned* st; };

__device__ __forceinline__ XcdBarrier xcd_barrier_post(unsigned* bar, volatile LAS unsigned* st) {
    XcdBarrier b; b.bar = bar; b.x = xb_xcc_id(); b.st = st;
    if (threadIdx.x == 0) (void)xb_add(&bar[XB_XCNT(b.x)], 1u);
    return b;
}
__device__ __forceinline__ void xcd_barrier_complete(unsigned* bar, unsigned x, unsigned& nloc, unsigned& nx) {
    const unsigned G = gridDim.x * gridDim.y * gridDim.z;
    unsigned sum, cnt, mine, sp = 0u;
    for (;;) {
        sum = 0u; cnt = 0u; mine = 0u;
#pragma unroll
        for (unsigned j = 0; j < 16; ++j) { const unsigned c = xb_ld(&bar[XB_XCNT(j)]); sum += c; cnt += (c > 0u) ? 1u : 0u; mine = (j == x) ? c : mine; }
        if (sum == G) break;
        __builtin_amdgcn_s_sleep(1);
        if ((++sp & 255u) == 0u) { if (xb_ld(&bar[XB_TMO])) break; if (sp > XB_SPIN_CAP) { atomicAdd(&bar[XB_TMO], 1u); break; } }
    }
    nloc = mine > 0u ? mine : 1u; nx = cnt > 0u ? cnt : 1u;
}
__device__ __forceinline__ void xcd_barrier(const XcdBarrier& b) {
    asm volatile("s_waitcnt vmcnt(0)" ::: "memory");
    __syncthreads();
    if (threadIdx.x == 0) {
        unsigned* bar = b.bar;
        __builtin_amdgcn_s_waitcnt(0);
        unsigned nloc = b.st[0], nx = b.st[1];
        if (nloc == 0u) { xcd_barrier_complete(bar, b.x, nloc, nx); b.st[0] = nloc; b.st[1] = nx; }
        const unsigned old = xb_add(&bar[XB_XSUB(b.x)], 1u);
        const unsigned gen = old / nloc;
        if (old + 1u == (gen + 1u) * nloc) {
            __builtin_amdgcn_fence(__ATOMIC_RELEASE, "agent");
            asm volatile("s_waitcnt vmcnt(0)" ::: "memory");
            const unsigned og = xb_add(&bar[XB_TOP], 1u);
            const unsigned tg = og / nx;
            if (og + 1u == (tg + 1u) * nx) xb_add(&bar[XB_TOPGEN], 1u);
            else XB_SPIN(xb_ld(&bar[XB_TOPGEN]) == tg, bar);
            __builtin_amdgcn_fence(__ATOMIC_ACQUIRE, "agent");
            xb_add(&bar[XB_XGEN(b.x)], 1u);
            asm volatile("s_waitcnt vmcnt(0)" ::: "memory");
        } else {
            XB_SPIN(xb_ld(&bar[XB_XGEN(b.x)]) == gen, bar);
            __builtin_amdgcn_fence(__ATOMIC_ACQUIRE, "agent");
            asm volatile("s_waitcnt vmcnt(0)" ::: "memory");
        }
    }
    __syncthreads();
}

__device__ __forceinline__ float wave_sum(float v) {
#pragma unroll
    for (int o = 1; o < 64; o <<= 1) v += __shfl_xor(v, o);
    return v;
}
__device__ __forceinline__ float half_swap_sum(float v) { const auto rr = __builtin_amdgcn_permlane32_swap(__float_as_uint(v), __float_as_uint(v), false, false); return __uint_as_float(rr[0]) + __uint_as_float(rr[1]); }
__device__ __forceinline__ float half_swap_max(float v) { const auto rr = __builtin_amdgcn_permlane32_swap(__float_as_uint(v), __float_as_uint(v), false, false); return fmaxf(__uint_as_float(rr[0]), __uint_as_float(rr[1])); }
__device__ __forceinline__ int crow(int r, int hi) { return (r & 3) + 8 * (r >> 2) + 4 * hi; }
__device__ __forceinline__ s16x4 tr_read(unsigned addr) { s16x4 r; asm volatile("ds_read_b64_tr_b16 %0, %1" : "=&v"(r) : "v"(addr) : "memory"); return r; }
#define PK8(L, H) (bf16x8){L[0], L[1], L[2], L[3], H[0], H[1], H[2], H[3]}

template <bool GATEMAP = false>
__device__ __forceinline__ void p0_transpose_item(const float* W, int K, int N, bf16* WT, LAS float* scr, int item, int lane) {
    const int nblk = N / 32, kb = item / nblk, nb = item % nblk, k0 = 64 * kb, n0 = 32 * nb;
    const int r0 = GATEMAP ? ((n0 < N / 2) ? 256 * (n0 / 128) + (n0 % 128) : 256 * ((n0 - N / 2) / 128) + 128 + ((n0 - N / 2) % 128)) : n0;
#pragma unroll 8
    for (int i = 0; i < 32; ++i) { const int kk = 2 * i + (lane >> 5); scr[kk * 33 + (lane & 31)] = W[(size_t)(k0 + kk) * N + n0 + (lane & 31)]; }
    LDS_WAIT(); asm volatile("" ::: "memory");
    const int c = lane & 7;
#pragma unroll
    for (int j = 0; j < 4; ++j) { const int n = (lane >> 3) + 8 * j; const LAS float* s = scr + (8 * c) * 33 + n;
        v4u o; o.x = pk2(s[0 * 33], s[1 * 33]); o.y = pk2(s[2 * 33], s[3 * 33]); o.z = pk2(s[4 * 33], s[5 * 33]); o.w = pk2(s[6 * 33], s[7 * 33]);
        *(GAS v4u*)(WT + (size_t)(r0 + n) * K + k0 + 8 * c) = o; }
    LDS_WAIT(); asm volatile("" ::: "memory");
}
__device__ __forceinline__ void rms_row_to_bf16(const float* xrow, const float* g, bf16* orow, int lane) {
    const GAS f32x4* xr = (const GAS f32x4*)xrow + lane; const GAS f32x4* gr = (const GAS f32x4*)g + lane;
    f32x4 v[16]; float s = 0.f;
#pragma unroll
    for (int j = 0; j < 16; ++j) { v[j] = xr[64 * j]; s += (v[j].x * v[j].x + v[j].y * v[j].y) + (v[j].z * v[j].z + v[j].w * v[j].w); }
    const float rstd = 1.0f / sqrtf(wave_sum(s) * (1.f / DM) + EPS);
    GAS v2u* o8 = (GAS v2u*)orow + lane;
#pragma unroll
    for (int j = 0; j < 16; ++j) { const f32x4 gg = gr[64 * j]; v2u w; w.x = pk2(v[j].x * rstd * gg.x, v[j].y * rstd * gg.y); w.y = pk2(v[j].z * rstd * gg.z, v[j].w * rstd * gg.w); o8[64 * j] = w; }
}
__device__ __forceinline__ void rms_row_inplace(float* xrow, const float* g, int lane) {
    GAS f32x4* xr = (GAS f32x4*)xrow + lane; const GAS f32x4* gr = (const GAS f32x4*)g + lane;
    f32x4 v[16]; float s = 0.f;
#pragma unroll
    for (int j = 0; j < 16; ++j) { v[j] = xr[64 * j]; s += (v[j].x * v[j].x + v[j].y * v[j].y) + (v[j].z * v[j].z + v[j].w * v[j].w); }
    const float rstd = 1.0f / sqrtf(wave_sum(s) * (1.f / DM) + EPS);
#pragma unroll
    for (int j = 0; j < 16; ++j) { const f32x4 gg = gr[64 * j]; xr[64 * j] = v[j] * rstd * gg; }
}

template <bool DIL>
__device__ __forceinline__ void attn_tile(f32x16 (&o)[4], float& m, float& l, const bf16x8 (&qf)[8], const bf16* kp, const bf16* vp, size_t vstride4, LAS unsigned char* img, float slope2d, int lane, int kt) {
    const int c = lane & 31, hi = lane >> 5;
    bf16x8 kf[8]; v4u vr[8];
#pragma unroll
    for (int ks = 0; ks < 8; ++ks) kf[ks] = *(const GAS bf16x8*)(kp + 16 * ks);
#pragma unroll
    for (int i = 0; i < 8; ++i) vr[i] = *(const GAS v4u*)(vp + (size_t)i * vstride4);
    f32x16 s;
#pragma unroll
    for (int i = 0; i < 16; ++i) s[i] = 0.f;
#pragma unroll
    for (int ks = 0; ks < 8; ++ks) s = __builtin_amdgcn_mfma_f32_32x32x16_bf16(kf[ks], qf[ks], s, 0, 0, 0);
    LAS unsigned char* wp = img + (lane >> 4) * IMG_PITCH + 16 * (lane & 15);
#pragma unroll
    for (int i = 0; i < 8; ++i) *(LAS v4u*)(wp + 4 * i * IMG_PITCH) = vr[i];
    if (DIL) {
        const int dbase = 32 * kt + 4 * hi - c;
#pragma unroll
        for (int i = 0; i < 16; ++i) { const int diff = dbase + crow(i, 0); const int adi = diff < 0 ? -diff : diff;
            const float v = s[i] - slope2d * (float)adi;
            s[i] = (adi <= 64) ? v : -1e30f; }
    }
    float mx = s[0];
#pragma unroll
    for (int i = 1; i < 16; ++i) mx = fmaxf(mx, s[i]);
    mx = half_swap_max(mx);
    const float mn = fmaxf(m, mx), alpha = __builtin_amdgcn_exp2f(m - mn);
    float ps = 0.f;
#pragma unroll
    for (int i = 0; i < 16; ++i) { s[i] = __builtin_amdgcn_exp2f(s[i] - mn); ps += s[i]; }
    ps = half_swap_sum(ps);
    l = l * alpha + ps; m = mn;
#pragma unroll
    for (int d = 0; d < 4; ++d)
#pragma unroll
        for (int i = 0; i < 16; ++i) o[d][i] *= alpha;
    v4u w0, w1;
    w0.x = pk2(s[0], s[1]); w0.y = pk2(s[2], s[3]); w0.z = pk2(s[4], s[5]); w0.w = pk2(s[6], s[7]);
    w1.x = pk2(s[8], s[9]); w1.y = pk2(s[10], s[11]); w1.z = pk2(s[12], s[13]); w1.w = pk2(s[14], s[15]);
    const bf16x8 pb0 = __builtin_bit_cast(bf16x8, w0), pb1 = __builtin_bit_cast(bf16x8, w1);
    const unsigned rb = (unsigned)(uintptr_t)img + (unsigned)((4 * hi + ((lane & 15) >> 2)) * IMG_PITCH + 32 * ((lane >> 4) & 1) + 8 * (lane & 3));
    LDS_WAIT(); SBAR();
#pragma unroll
    for (int s2 = 0; s2 < 2; ++s2) {
        s16x4 a[4][2];
#pragma unroll
        for (int d = 0; d < 4; ++d)
#pragma unroll
            for (int t = 0; t < 2; ++t) a[d][t] = tr_read(rb + (unsigned)((16 * s2 + 8 * t) * IMG_PITCH + 64 * d));
        LDS_WAIT(); SBAR();
#pragma unroll
        for (int d = 0; d < 4; ++d) o[d] = __builtin_amdgcn_mfma_f32_32x32x16_bf16(PK8(a[d][0], a[d][1]), s2 ? pb1 : pb0, o[d], 0, 0, 0);
    }
}

__device__ __forceinline__ void attn_store(const f32x16 (&o)[4], float l, bf16* orow, int hi) {
    const float inv = 1.0f / l;
#pragma unroll
    for (int d = 0; d < 4; ++d)
#pragma unroll
        for (int g4 = 0; g4 < 4; ++g4) { v2u w; w.x = pk2(o[d][4 * g4] * inv, o[d][4 * g4 + 1] * inv); w.y = pk2(o[d][4 * g4 + 2] * inv, o[d][4 * g4 + 3] * inv);
            *(GAS v2u*)(orow + 32 * d + 8 * g4 + 4 * hi) = w; }
}

struct Args { const float* in[24]; float* out; unsigned char* ws; int ph_lo, ph_hi; };
enum { I_XP = 0, I_XS, I_MEMP, I_MEMS, I_NMIXG, I_WIN, I_SGLNG, I_SGLNB, I_SGW, I_SGB, I_GAG, I_GBG, I_WOUT, I_NXG, I_MEMG, I_WXQ, I_WXKV, I_WXO, I_NFFNG, I_WUP, I_CONVW, I_CONVB, I_WDN, I_FING };

__global__ void __launch_bounds__(NWAVES * 64, 2) fwd_kernel(Args args) {
    extern __shared__ __attribute__((aligned(16))) unsigned char lds_raw[];
    LAS unsigned char* lds = (LAS unsigned char*)lds_raw;
    volatile LAS unsigned* MISC = (volatile LAS unsigned*)(lds + MISC_OFF);
    const int tid = threadIdx.x, lane = tid & 63, wave = __builtin_amdgcn_readfirstlane(tid >> 6);
    const int G = gridDim.x, gw = blockIdx.x * NWAVES + wave, NGW = G * NWAVES;
    unsigned char* ws = args.ws;
    gu32* ctl = (gu32*)(ws + WS_CTL);
    bf16* SGWB = (bf16*)(ws + WS_SGW);
    bf16* Win_t = (bf16*)(ws + WS_WIN); bf16* Wout_t = (bf16*)(ws + WS_WOUT); bf16* Wxq_t = (bf16*)(ws + WS_WXQ); bf16* Wxkv_t = (bf16*)(ws + WS_WXKV);
    bf16* Wxo_t = (bf16*)(ws + WS_WXO); bf16* Wup_t = (bf16*)(ws + WS_WUP); bf16* Wdn_t = (bf16*)(ws + WS_WDN);
    bf16* HN = (bf16*)(ws + WS_HN); bf16* PROJ = (bf16*)(ws + WS_PROJ); bf16* MEMN = (bf16*)(ws + WS_MEMN); bf16* KVX = (bf16*)(ws + WS_KVX);
    bf16* QX = (bf16*)(ws + WS_PROJ + PJ_QX); bf16* OX = (bf16*)(ws + WS_PROJ + PJ_OX); bf16* GB = (bf16*)(ws + WS_PROJ); float* EDGE = (float*)(ws + WS_EDGE);
    float* OUT = args.out;
    unsigned char* outb = (unsigned char*)args.out;
    float* LSE = (float*)(outb + OUT_LSE);
    bf16* H2 = (bf16*)(ws + WS_PROJ + PJ_H2);
    float* SSQ1 = (float*)(ws + WS_CTL) + CW_SSQ1; float* SSQ2 = (float*)(ws + WS_CTL) + CW_SSQ2; float* SSQ3 = (float*)(ws + WS_CTL) + CW_SSQ3;

    for (int u = tid; u < (LDS_BYTES - LDSCTL_OFF) / 4; u += NWAVES * 64) ((LAS unsigned*)(lds + LDSCTL_OFF))[u] = 0u;
    __syncthreads();
    XcdBarrier bar = xcd_barrier_post((unsigned*)(ctl + CW_BAR), MISC + 8);
#define GRID_BAR() xcd_barrier(bar)
    const int lo = args.ph_lo, hi_ph = args.ph_hi;
#ifdef PHMASK
#define IN(k) ((PHMASK >> (k)) & 1)
#else
#define IN(k) (lo <= (k) && (k) < hi_ph)
#endif

    if (IN(0)) {
        LAS float* scr = (LAS float*)(lds + RING_OFF + wave * 16384);
        constexpr int I_1 = (DM / 64) * (INW / 32), I_2 = (DM / 64) * (DM / 32), I_3 = (DM / 64) * (XW / 32), I_4 = (DM / 64) * (2 * XW / 32), I_5 = (XW / 64) * (DM / 32),
                      I_6 = (DM / 64) * (2 * DFF / 32), I_7 = (DFF / 64) * (DM / 32);
        constexpr int NITEMS = I_1 + I_2 + I_3 + I_4 + I_5 + I_6 + I_7;
        for (int it = gw; it < NITEMS; it += NGW) {
            int r = it;
            if (r < I_1) { p0_transpose_item(args.in[I_WIN], DM, INW, Win_t, scr, r, lane); continue; } r -= I_1;
            if (r < I_2) { p0_transpose_item(args.in[I_WOUT], DM, DM, Wout_t, scr, r, lane); continue; } r -= I_2;
            if (r < I_3) { p0_transpose_item(args.in[I_WXQ], DM, XW, Wxq_t, scr, r, lane); continue; } r -= I_3;
            if (r < I_4) { p0_transpose_item(args.in[I_WXKV], DM, 2 * XW, Wxkv_t, scr, r, lane); continue; } r -= I_4;
            if (r < I_5) { p0_transpose_item(args.in[I_WXO], XW, DM, Wxo_t, scr, r, lane); continue; } r -= I_5;
            if (r < I_6) { p0_transpose_item<true>(args.in[I_WUP], DM, 2 * DFF, Wup_t, scr, r, lane); continue; } r -= I_6;
            p0_transpose_item(args.in[I_WDN], DFF, DM, Wdn_t, scr, r, lane);
        }
        for (int i = blockIdx.x * 512 + tid; i < NHEAD * 128 * 128 / 2; i += G * 512) { const float2 v = ((const float2*)args.in[I_SGW])[i]; ((unsigned*)SGWB)[i] = pk2(v.x, v.y); }
        for (int mrow = gw; mrow < MTOK; mrow += NGW) {
            const float* xr = mrow < MPROMPT ? args.in[I_XP] + (size_t)mrow * DM : args.in[I_XS] + (size_t)(mrow - MPROMPT) * DM;
            rms_row_to_bf16(xr, args.in[I_NMIXG], HN + (size_t)mrow * DM, lane); }
        for (int mrow = gw; mrow < NMEMROWS; mrow += NGW) {
            const float* xr = mrow < 256 ? args.in[I_MEMP] + (size_t)mrow * DM : args.in[I_MEMS] + (size_t)(mrow - 256) * DM;
            rms_row_to_bf16(xr, args.in[I_MEMG], MEMN + (size_t)mrow * DM, lane); }
        GRID_BAR();
    }

    if (IN(1)) {
        { pg8::Gemm g{HN, Win_t, MTOK, INW, DM}; pg8::StaticOrder S; S.init(MTOK, INW, G, (int)blockIdx.x);
          pg8::EpiInProj E{PROJ, INW, QSCALE};
          pg8::gemm_phase<pg8::EpiInProj, pg8::StaticOrder, true, true>(lds + RING_OFF, g, S, E); }
        { pg8::Gemm g{MEMN, Wxkv_t, NMEMROWS, 2 * XW, DM}; pg8::StaticOrder S; S.init(NMEMROWS, 2 * XW, G, (int)blockIdx.x);
          pg8::EpiBf16S E{KVX, 2 * XW, 1.0f, nullptr};
          pg8::gemm_phase<pg8::EpiBf16S, pg8::StaticOrder, true, true>(lds + RING_OFF, g, S, E); }
        GRID_BAR();
    }

    if (IN(2)) {
#ifndef NO_SG
        LAS float* stat_mean = (LAS float*)(lds + 81920); LAS float* stat_rstd = stat_mean + 128; LAS float* ssqL = stat_mean + 256;
        const float* lng = args.in[I_SGLNG]; const float* lnb = args.in[I_SGLNB]; const float* sgb = args.in[I_SGB]; const float* gag = args.in[I_GAG];
        for (int ck = blockIdx.x; ck < MTOK / 128; ck += G) {
            const int R0 = ck * 128;
#pragma unroll 4
            for (int rr = 0; rr < 16; ++rr) { const int srow = wave * 16 + rr; const GAS v4u* vp = (const GAS v4u*)(PROJ + (size_t)(R0 + srow) * INW + AWID) + lane;
                float x[32]; float sm = 0.f;
#pragma unroll
                for (int j = 0; j < 4; ++j) { const v4u w = vp[64 * j];
                    x[8 * j + 0] = bflo(w.x); x[8 * j + 1] = bfhi(w.x); x[8 * j + 2] = bflo(w.y); x[8 * j + 3] = bfhi(w.y); x[8 * j + 4] = bflo(w.z); x[8 * j + 5] = bfhi(w.z); x[8 * j + 6] = bflo(w.w); x[8 * j + 7] = bfhi(w.w); }
#pragma unroll
                for (int j = 0; j < 32; ++j) sm += x[j];
                const float mean = wave_sum(sm) * (1.f / AWID); float sq = 0.f;
#pragma unroll
                for (int j = 0; j < 32; ++j) { const float d = x[j] - mean; sq += d * d; }
                const float rstd = 1.0f / sqrtf(wave_sum(sq) * (1.f / AWID) + EPS);
                if (lane == 0) { stat_mean[srow] = mean; stat_rstd[srow] = rstd; } }
            __syncthreads();
            const int hh = wave >> 2, tb = wave & 3, c = lane & 31, hi = lane >> 5;
            float ssq = 0.f;
            for (int hp = 0; hp < 8; ++hp) {
                { const int ch32 = tid & 31, colbase = 256 * hp + 8 * ch32;
                  float gv[8], bv[8];
#pragma unroll
                  for (int j = 0; j < 8; ++j) { gv[j] = lng[colbase + j]; bv[j] = lnb[colbase + j]; }
                  LAS unsigned char* ib = lds + (ch32 >> 4) * (128 * IMG_PITCH) + 16 * (ch32 & 15);
#pragma unroll
                  for (int i = 0; i < 8; ++i) { const int srow = (tid >> 5) + 16 * i;
                      const v4u w = *(const GAS v4u*)(PROJ + (size_t)(R0 + srow) * INW + AWID + colbase);
                      const float mu = stat_mean[srow], rs = stat_rstd[srow];
                      v4u o;
                      o.x = pk2((bflo(w.x) - mu) * rs * gv[0] + bv[0], (bfhi(w.x) - mu) * rs * gv[1] + bv[1]);
                      o.y = pk2((bflo(w.y) - mu) * rs * gv[2] + bv[2], (bfhi(w.y) - mu) * rs * gv[3] + bv[3]);
                      o.z = pk2((bflo(w.z) - mu) * rs * gv[4] + bv[4], (bfhi(w.z) - mu) * rs * gv[5] + bv[5]);
                      o.w = pk2((bflo(w.w) - mu) * rs * gv[6] + bv[6], (bfhi(w.w) - mu) * rs * gv[7] + bv[7]);
                      *(LAS v4u*)(ib + srow * IMG_PITCH) = o; } }
                __syncthreads();
                { int lz = lane; asm volatile("" : "+v"(lz)); const int c = lz & 31, hi = lz >> 5;
                  const int g = 2 * hp + hh, t = 32 * tb + c;
                  bf16x8 wf[8];
                  const bf16* wrow = SGWB + ((size_t)(g * 128 + t)) * 128 + 8 * hi;
#pragma unroll
                  for (int ks = 0; ks < 8; ++ks) wf[ks] = *(const GAS bf16x8*)(wrow + 16 * ks);
                  f32x16 acc[4];
#pragma unroll
                  for (int d = 0; d < 4; ++d)
#pragma unroll
                      for (int i = 0; i < 16; ++i) acc[d][i] = 0.f;
                  const unsigned rb = (unsigned)(uintptr_t)(lds + hh * (128 * IMG_PITCH)) + (unsigned)((8 * hi + ((lz & 15) >> 2)) * IMG_PITCH + 32 * ((lz >> 4) & 1) + 8 * (lz & 3));
#pragma unroll
                  for (int ks = 0; ks < 8; ++ks) {
                      s16x4 a[4][2];
#pragma unroll
                      for (int d = 0; d < 4; ++d)
#pragma unroll
                          for (int tt = 0; tt < 2; ++tt) a[d][tt] = tr_read(rb + (unsigned)((16 * ks + 4 * tt) * IMG_PITCH + 64 * d));
                      LDS_WAIT(); SBAR();
#pragma unroll
                      for (int d = 0; d < 4; ++d) acc[d] = __builtin_amdgcn_mfma_f32_32x32x16_bf16(PK8(a[d][0], a[d][1]), wf[ks], acc[d], 0, 0, 0);
                  }
                  const float bs = sgb[g * 128 + t];
                  const bf16* urow = PROJ + (size_t)(R0 + t) * INW + g * 128 + 4 * hi;
                  bf16* orow = HN + (size_t)(R0 + t) * DM + g * 128 + 4 * hi;
#pragma unroll
                  for (int d = 0; d < 4; ++d)
#pragma unroll
                      for (int g4 = 0; g4 < 4; ++g4) { const v2u uu = *(const GAS v2u*)(urow + 32 * d + 8 * g4);
                          const float a0 = bflo(uu.x) * (acc[d][4 * g4] + bs), a1 = bfhi(uu.x) * (acc[d][4 * g4 + 1] + bs), a2 = bflo(uu.y) * (acc[d][4 * g4 + 2] + bs), a3 = bfhi(uu.y) * (acc[d][4 * g4 + 3] + bs);
                          ssq += (a0 * a0 + a1 * a1) + (a2 * a2 + a3 * a3);
                          v2u w; w.x = pk2(a0, a1); w.y = pk2(a2, a3); *(GAS v2u*)(orow + 32 * d + 8 * g4) = w; }
                }
                __syncthreads();
            }
            ssq = half_swap_sum(ssq);
            if (hi == 0) ssqL[hh * 128 + 32 * tb + c] = ssq;
            VM_WAIT();
            __syncthreads();
            { const int cc = tid & 255;
              float gg[8];
#pragma unroll
              for (int j = 0; j < 8; ++j) gg[j] = gag[8 * cc + j];
#pragma unroll 8
              for (int i = 0; i < 64; ++i) { const int t = (tid >> 8) + 2 * i; const float rs = 1.0f / sqrtf((ssqL[t] + ssqL[128 + t]) * (1.f / AWID) + EPS);
                  GAS v4u* p = (GAS v4u*)(HN + (size_t)(R0 + t) * DM + 8 * cc); const v4u w = *p; v4u o;
                  o.x = pk2(bflo(w.x) * rs * gg[0], bfhi(w.x) * rs * gg[1]); o.y = pk2(bflo(w.y) * rs * gg[2], bfhi(w.y) * rs * gg[3]);
                  o.z = pk2(bflo(w.z) * rs * gg[4], bfhi(w.z) * rs * gg[5]); o.w = pk2(bflo(w.w) * rs * gg[6], bfhi(w.w) * rs * gg[7]); *p = o; } }
            __syncthreads();
        }
#endif
#ifndef NO_DIL
        { LAS unsigned char* img = lds + wave * (32 * IMG_PITCH);
          const int c = lane & 31, hi = lane >> 5;
          constexpr int NITEM = 3 * NHEAD * (MTOK / 32);
          const int ipw = (NITEM + NGW - 1) / NGW; const int it0 = gw * ipw, it1 = (it0 + ipw < NITEM) ? it0 + ipw : NITEM;
          for (int it = it0; it < it1; ++it) {
              const int p = it / (NHEAD * 1024), rem = it % (NHEAD * 1024), h = rem / 1024, tbk = rem % 1024;
              const int d = (p == 0) ? 1 : (p == 1 ? 4 : 16);
              int base, S, local;
              if (tbk < 512) { base = 0; S = MPROMPT; local = tbk; } else { base = MPROMPT + SEQ_S * ((tbk - 512) >> 6); S = SEQ_S; local = (tbk - 512) & 63; }
              const int nq = S / d, bpr = nq / 32, r = local / bpr, qb = local % bpr;
              const float slope2d = __builtin_amdgcn_exp2f(-0.5f * (float)(h + 1)) * LOG2E * (float)d;
              const size_t rowq = (size_t)(base + (32 * qb + c) * d + r);
              bf16x8 qf[8];
              { const bf16* qp = PROJ + rowq * INW + QOFF + h * HD + 8 * hi;
#pragma unroll
                for (int ks = 0; ks < 8; ++ks) qf[ks] = *(const GAS bf16x8*)(qp + 16 * ks); }
              f32x16 o[4];
#pragma unroll
              for (int dd = 0; dd < 4; ++dd)
#pragma unroll
                  for (int i = 0; i < 16; ++i) o[dd][i] = 0.f;
              float m = -1e30f, l = 0.f;
              const size_t vstride4 = (size_t)4 * d * INW;
#pragma unroll 1
              for (int j = 0; j < 5; ++j) { const int kt = (j & 1) ? -((j + 1) >> 1) : (j >> 1);
                  const int n0 = 32 * (qb + kt); if (n0 < 0 || n0 >= nq) continue;
                  const bf16* kp = PROJ + (size_t)(base + (n0 + c) * d + r) * INW + KOFF + h * HD + 8 * hi;
                  const bf16* vp = PROJ + (size_t)(base + (n0 + (lane >> 4)) * d + r) * INW + VOFF + h * HD + 8 * (lane & 15);
                  attn_tile<true>(o, m, l, qf, kp, vp, vstride4, img, slope2d, lane, kt); }
              attn_store(o, l, (bf16*)(outb + OUT_OP + (size_t)p * OP_STRIDE) + rowq * BWID + h * HD, hi);
              if (hi == 0) LSE[((size_t)p * MTOK + rowq) * NHEAD + h] = m + __builtin_amdgcn_logf(l);
          } }
#endif
        GRID_BAR();
    }

    if (IN(3)) {
        const float* gbg = args.in[I_GBG];
        for (int row = gw; row < MTOK; row += NGW) {
            const int h = lane >> 2;
            const float l0 = LSE[((size_t)0 * MTOK + row) * NHEAD + h], l1 = LSE[((size_t)1 * MTOK + row) * NHEAD + h], l2 = LSE[((size_t)2 * MTOK + row) * NHEAD + h];
            const float mx = fmaxf(l0, fmaxf(l1, l2));
            float w0 = __builtin_amdgcn_exp2f(l0 - mx), w1 = __builtin_amdgcn_exp2f(l1 - mx), w2 = __builtin_amdgcn_exp2f(l2 - mx);
            const float inv = 1.0f / (w0 + w1 + w2); w0 *= inv; w1 *= inv; w2 *= inv;
            float b[32];
#pragma unroll
            for (int j = 0; j < 32; ++j) b[j] = 0.f;
#pragma unroll
            for (int p = 0; p < 3; ++p) { const float wp = p == 0 ? w0 : (p == 1 ? w1 : w2);
                const GAS v4u* op = (const GAS v4u*)((const bf16*)(outb + OUT_OP + (size_t)p * OP_STRIDE) + (size_t)row * BWID + 32 * lane);
#pragma unroll
                for (int j = 0; j < 4; ++j) { const v4u w = op[j];
                    b[8 * j + 0] += wp * bflo(w.x); b[8 * j + 1] += wp * bfhi(w.x); b[8 * j + 2] += wp * bflo(w.y); b[8 * j + 3] += wp * bfhi(w.y);
                    b[8 * j + 4] += wp * bflo(w.z); b[8 * j + 5] += wp * bfhi(w.z); b[8 * j + 6] += wp * bflo(w.w); b[8 * j + 7] += wp * bfhi(w.w); } }
            float sq = 0.f;
#pragma unroll
            for (int j = 0; j < 32; ++j) sq += b[j] * b[j];
            const float rs = 1.0f / sqrtf(wave_sum(sq) * (1.f / BWID) + EPS);
            GAS v4u* dst = (GAS v4u*)(HN + (size_t)row * DM + AWID + 32 * lane);
            const GAS f32x4* gp = (const GAS f32x4*)(gbg + 32 * lane);
#pragma unroll
            for (int j = 0; j < 4; ++j) { const f32x4 ga = gp[2 * j], gc = gp[2 * j + 1]; v4u o;
                o.x = pk2(b[8 * j + 0] * rs * ga.x, b[8 * j + 1] * rs * ga.y); o.y = pk2(b[8 * j + 2] * rs * ga.z, b[8 * j + 3] * rs * ga.w);
                o.z = pk2(b[8 * j + 4] * rs * gc.x, b[8 * j + 5] * rs * gc.y); o.w = pk2(b[8 * j + 6] * rs * gc.z, b[8 * j + 7] * rs * gc.w); dst[j] = o; }
        }
        GRID_BAR();
    }

    if (IN(4)) {
        pg8::Gemm g{HN, Wout_t, MTOK, DM, DM}; pg8::StaticOrder S; S.init(MTOK, DM, G, (int)blockIdx.x);
        pg8::EpiResNorm E{args.in[I_XP], args.in[I_XS], MPROMPT / 256, OUT, DM, H2, args.in[I_NXG], SSQ1};
        pg8::gemm_phase<pg8::EpiResNorm, pg8::StaticOrder, true, true>(lds + RING_OFF, g, S, E);
        GRID_BAR();
    }
    if (IN(6)) {
        pg8::Gemm g{H2, Wxq_t, MTOK, XW, DM}; pg8::StaticOrder S; S.init(MTOK, XW, G, (int)blockIdx.x);
        pg8::EpiBf16S E{QX, XW, QSCALE, SSQ1};
        pg8::gemm_phase<pg8::EpiBf16S, pg8::StaticOrder, true, true>(lds + RING_OFF, g, S, E);
        GRID_BAR();
    }
    if (IN(7)) {
        LAS unsigned char* img = lds + wave * (32 * IMG_PITCH);
        const int c = lane & 31, hi = lane >> 5;
        constexpr int NITEM = XHEADS * (MTOK / 32);
        const int ipw = (NITEM + NGW - 1) / NGW; const int it0 = gw * ipw, it1 = (it0 + ipw < NITEM) ? it0 + ipw : NITEM;
        for (int it = it0; it < it1; ++it) {
            const int xh = it / 1024, tbk = it % 1024, R = 32 * tbk;
            const int mrow0 = (R < MPROMPT) ? 0 : 256 + 256 * ((R - MPROMPT) / SEQ_S);
            bf16x8 qf[8];
            { const bf16* qp = QX + (size_t)(R + c) * XW + xh * HD + 8 * hi;
#pragma unroll
              for (int ks = 0; ks < 8; ++ks) qf[ks] = *(const GAS bf16x8*)(qp + 16 * ks); }
            f32x16 o[4];
#pragma unroll
            for (int dd = 0; dd < 4; ++dd)
#pragma unroll
                for (int i = 0; i < 16; ++i) o[dd][i] = 0.f;
            float m = -1e30f, l = 0.f;
            for (int kt = 0; kt < 8; ++kt) {
                const bf16* kp = KVX + (size_t)(mrow0 + 32 * kt + c) * (2 * XW) + xh * HD + 8 * hi;
                const bf16* vp = KVX + (size_t)(mrow0 + 32 * kt + (lane >> 4)) * (2 * XW) + XW + xh * HD + 8 * (lane & 15);
                attn_tile<false>(o, m, l, qf, kp, vp, (size_t)4 * 2 * XW, img, 0.f, lane, 0);
            }
            attn_store(o, l, OX + (size_t)(R + c) * XW + xh * HD, hi);
        }
        GRID_BAR();
    }
    if (IN(8)) {
        pg8::Gemm g{OX, Wxo_t, MTOK, DM, XW}; pg8::StaticOrder S; S.init(MTOK, DM, G, (int)blockIdx.x);
        pg8::EpiResNorm E{OUT, OUT, 1 << 30, OUT, DM, HN, args.in[I_NFFNG], SSQ2};
        pg8::gemm_phase<pg8::EpiResNorm, pg8::StaticOrder, true, true>(lds + RING_OFF, g, S, E);
        GRID_BAR();
    }
    if (IN(10)) {
        const float* cw = args.in[I_CONVW]; const float* cb = args.in[I_CONVB];
        { pg8::Gemm g{HN, Wup_t, MTOK, 2 * DFF, DM}; pg8::StaticOrder S; S.init(MTOK, 2 * DFF, G, (int)blockIdx.x);
          pg8::EpiConvGate E{GB, SSQ2, cw, cb, EDGE, (LAS float*)(lds + XCH_OFF), DFF};
          pg8::gemm_phase<pg8::EpiConvGate, pg8::StaticOrder, true, true>(lds + RING_OFF, g, S, E); }
        GRID_BAR();
        { constexpr int NC4 = DFF / 4, LDW = 2 * DFF;
          for (int item = blockIdx.x * 512 + tid; item < (MTOK / 256) * 2 * NC4; item += G * 512) {
              const int c4 = item % NC4, pe = item / NC4, pm = pe >> 1, bot = pe & 1, col = 4 * c4, t = 256 * pm + (bot ? 255 : 0);
              const bool has_prev = (t < MPROMPT) ? (t != 0) : ((t & (SEQ_S - 1)) != 0), has_next = (t < MPROMPT) ? (t != MPROMPT - 1) : ((t & (SEQ_S - 1)) != SEQ_S - 1);
              const float* ep = EDGE + (size_t)pm * 4 * LDW;
              const f32x4 z4 = {0.f, 0.f, 0.f, 0.f};
              f32x4 pg, pv, cg4, cv4, ng, nv;
              if (!bot) { const float* pp = ep - LDW;
                  pg = has_prev ? *(const GAS f32x4*)(pp + col) : z4; pv = has_prev ? *(const GAS f32x4*)(pp + DFF + col) : z4;
                  cg4 = *(const GAS f32x4*)(ep + col); cv4 = *(const GAS f32x4*)(ep + DFF + col); ng = *(const GAS f32x4*)(ep + LDW + col); nv = *(const GAS f32x4*)(ep + LDW + DFF + col); }
              else { const float* np_ = ep + 4 * LDW;
                  pg = *(const GAS f32x4*)(ep + 2 * LDW + col); pv = *(const GAS f32x4*)(ep + 2 * LDW + DFF + col); cg4 = *(const GAS f32x4*)(ep + 3 * LDW + col); cv4 = *(const GAS f32x4*)(ep + 3 * LDW + DFF + col);
                  ng = has_next ? *(const GAS f32x4*)(np_ + col) : z4; nv = has_next ? *(const GAS f32x4*)(np_ + DFF + col) : z4; }
              const f32x4 zg = pg * *(const GAS f32x4*)(cw + col) + cg4 * *(const GAS f32x4*)(cw + LDW + col) + ng * *(const GAS f32x4*)(cw + 2 * LDW + col) + *(const GAS f32x4*)(cb + col);
              const f32x4 zv = pv * *(const GAS f32x4*)(cw + DFF + col) + cv4 * *(const GAS f32x4*)(cw + LDW + DFF + col) + nv * *(const GAS f32x4*)(cw + 2 * LDW + DFF + col) + *(const GAS f32x4*)(cb + DFF + col);
              float gg[4];
#pragma unroll
              for (int j = 0; j < 4; ++j) gg[j] = zg[j] * __builtin_amdgcn_rcpf(1.0f + __builtin_amdgcn_exp2f(-LOG2E * zg[j])) * zv[j];
              v2u o; o.x = pk2(gg[0], gg[1]); o.y = pk2(gg[2], gg[3]);
              *(GAS v2u*)(GB + (size_t)t * DFF + col) = o;
          } }
        GRID_BAR();
        { pg8::Gemm g{GB, Wdn_t, MTOK, DM, DFF}; pg8::StaticOrder S; S.init(MTOK, DM, G, (int)blockIdx.x);
          pg8::EpiResNorm E{OUT, OUT, 1 << 30, OUT, DM, nullptr, nullptr, SSQ3};
          pg8::gemm_phase<pg8::EpiResNorm, pg8::StaticOrder, true, true>(lds + RING_OFF, g, S, E); }
        GRID_BAR();
    }
    if (IN(11)) {
        const GAS f32x4* gp = (const GAS f32x4*)args.in[I_FING]; GAS f32x4* op = (GAS f32x4*)OUT;
        const int nth = G * 512;
        for (int i0 = blockIdx.x * 512 + tid; i0 < MTOK * (DM / 4); i0 += 4 * nth) {
            f32x4 v[4];
#pragma unroll
            for (int k = 0; k < 4; ++k) v[k] = op[i0 + k * nth];
#pragma unroll
            for (int k = 0; k < 4; ++k) { const int i = i0 + k * nth; const float rs = __builtin_amdgcn_rsqf(SSQ3[i >> 10] * (1.0f / DM) + EPS); op[i] = v[k] * rs * gp[i & 1023]; }
        }
    }
#undef IN
#undef GRID_BAR
}

extern "C" void kernel_launch(void* const* d_in, const int* in_sizes, int n_in, void* d_out, int out_size, void* d_ws, size_t ws_size, hipStream_t stream) {
    static int grid = 0;
    if (grid == 0) {
        if (n_in != 24 || out_size != MTOK * DM || ws_size < WS_END) { fprintf(stderr, "kernel_launch: unexpected shapes (n_in %d, out %d, ws %zu)\n", n_in, out_size, ws_size); grid = -1; return; }
        int dev = 0, cus = 0, per_cu = 0;
        if (hipGetDevice(&dev) != hipSuccess || hipDeviceGetAttribute(&cus, hipDeviceAttributeMultiprocessorCount, dev) != hipSuccess) { grid = -1; return; }
        if (hipFuncSetAttribute((const void*)fwd_kernel, hipFuncAttributeMaxDynamicSharedMemorySize, LDS_BYTES) != hipSuccess) { fprintf(stderr, "kernel_launch: hipFuncSetAttribute failed\n"); grid = -1; return; }
        if (hipOccupancyMaxActiveBlocksPerMultiprocessor(&per_cu, (const void*)fwd_kernel, NWAVES * 64, LDS_BYTES) != hipSuccess || per_cu < 1) { fprintf(stderr, "kernel_launch: occupancy query reports %d\n", per_cu); }
        (void)hipGetLastError();
        grid = cus;
    }
    if (grid < 0) return;
    if (hipMemsetAsync((char*)d_ws + WS_CTL, 0, CTL_ZERO_BYTES, stream) != hipSuccess) { fprintf(stderr, "kernel_launch: memset failed\n"); return; }
    Args a{};
    for (int i = 0; i < 24; ++i) a.in[i] = (const float*)d_in[i];
    a.out = (float*)d_out; a.ws = (unsigned char*)d_ws; a.ph_lo = 0; a.ph_hi = 12;
    hipLaunchKernelGGL(fwd_kernel, dim3(grid), dim3(NWAVES * 64), LDS_BYTES, stream, a);
    const hipError_t le = hipPeekAtLastError();
    if (le != hipSuccess) fprintf(stderr, "kernel_launch: launch failed: %s\n", hipGetErrorName(le));
}
```

```cpp
#include <hip/hip_runtime.h>
#include <cstdio>
#include <cstdint>
namespace pg8 {
#define PG8_LAS __attribute__((address_space(3)))
typedef unsigned short bf16_t;
typedef short bf16x8 __attribute__((ext_vector_type(8)));
typedef float f32x4 __attribute__((ext_vector_type(4)));
typedef unsigned u32x4 __attribute__((ext_vector_type(4)));
constexpr int BM = 256, BK = 64, HALF = 128, HTB = HALF * BK * 2  , STAGE_BYTES = 8 * HTB, NXCD = 8, WGM = 8;

__host__ __device__ __forceinline__ int lds_byte(int r, int c) { const int st = (r >> 4) * 2 + (c >> 5), rr = r & 15, cc = c & 31, ob = rr * 64 + cc * 2; return st * 1024 + (ob ^ (((ob >> 9) & 1) << 5)); }
__host__ __device__ __forceinline__ void stage_rc(int b, int& R, int& C) { const int st = b / 1024, sb = b % 1024, swz = sb ^ (((sb >> 9) & 1) << 5); R = (st >> 1) * 16 + swz / 64; C = (st & 1) * 32 + (swz % 64) / 2; }
__host__ __device__ __forceinline__ int perm32(int rho) { const int n = rho >> 4, i = rho & 15; return 8 * (i >> 2) + 4 * n + (i & 3); }

struct Unit { int pm, pn; };
struct Gemm { const bf16_t* A; const bf16_t* Bt; int M, N, K; };

struct StaticOrder {
    int nM, nN, nwg, G, c;
    __host__ __device__ void init(int M, int N, int G_, int c_) { nM = M / BM; nN = N / BM; nwg = nM * nN; G = G_; c = c_; }
    __host__ __device__ bool next(int i, Unit& u) const {
        const long L = (long)i * G + c; if (L >= nwg) return false;
        int wgid = (int)L; { const int q = nwg / NXCD, r = nwg % NXCD, xcd = wgid % NXCD, off = wgid / NXCD; wgid = (xcd < r ? xcd * (q + 1) : r * (q + 1) + (xcd - r) * q) + off; }
        const int nig = WGM * nN, gid = wgid / nig, fm = gid * WGM, gsz = (nM - fm) < WGM ? (nM - fm) : WGM;
        u.pm = fm + ((wgid % nig) % gsz); u.pn = (wgid % nig) / gsz; return true;
    }
    __device__ __forceinline__ void a_ready(const Unit&) const {}
    __device__ __forceinline__ void done(const Unit&) const {}
};

typedef float f32x2 __attribute__((ext_vector_type(2)));
typedef __bf16 bf16x2v __attribute__((ext_vector_type(2)));
__device__ __forceinline__ unsigned cvt_pk_bf16(float lo, float hi) { const f32x2 v = {lo, hi}; return __builtin_bit_cast(unsigned, __builtin_convertvector(v, bf16x2v)); }
__device__ __forceinline__ float gelu_tanh(float x) {
    const float t = x * (1.0f + 0.044715f * x * x) * (-2.3022082f);
    return x * __builtin_amdgcn_rcpf(1.0f + __builtin_amdgcn_exp2f(t));
}
struct EpiInProj {
    static constexpr bool PERM = true, AFTER_DRAIN = false;
    bf16_t* UV; bf16_t* QKV; int mtok; float qscale;
    __device__ __forceinline__ void operator()(const f32x4 (&acc)[2][2][4][2], const Unit& u, int wr, int wc, int fr, int fq) const {
        const int row0 = u.pm * BM + wr * 64 + fr;
        const bool do_gelu = u.pn < 16; const float sc = (u.pn >= 16 && u.pn < 24) ? qscale : 1.0f;
        const int pitch = do_gelu ? 4096 : 128; const size_t bjstep = do_gelu ? (size_t)HALF : (size_t)mtok * 128;
        bf16_t* O = do_gelu ? UV + u.pn * BM + wc * 32 + 8 * fq : QKV + (size_t)(2 * (u.pn - 16)) * mtok * 128 + wc * 32 + 8 * fq;
#pragma unroll
        for (int ai = 0; ai < 2; ++ai)
#pragma unroll
            for (int m = 0; m < 4; ++m) { bf16_t* rowp = O + (size_t)(row0 + ai * HALF + m * 16) * pitch;
#pragma unroll
                for (int bj = 0; bj < 2; ++bj) { f32x4 v0 = acc[ai][bj][m][0], v1 = acc[ai][bj][m][1];
                    if (do_gelu) {
#pragma unroll
                        for (int j = 0; j < 4; ++j) { v0[j] = gelu_tanh(v0[j]); v1[j] = gelu_tanh(v1[j]); } }
                    else { v0 = v0 * sc; v1 = v1 * sc; }
                    u32x4 w; w.x = cvt_pk_bf16(v0[0], v0[1]); w.y = cvt_pk_bf16(v0[2], v0[3]); w.z = cvt_pk_bf16(v1[0], v1[1]); w.w = cvt_pk_bf16(v1[2], v1[3]);
                    *(u32x4*)(rowp + bj * bjstep) = w; } }
    }
};
struct EpiBf16S {
    static constexpr bool PERM = true, AFTER_DRAIN = false;
    bf16_t* O; int ldc; float scale0; const float* ssq;
    __device__ __forceinline__ void operator()(const f32x4 (&acc)[2][2][4][2], const Unit& u, int wr, int wc, int fr, int fq) const {
        const int row0 = u.pm * BM + wr * 64 + fr, col0 = u.pn * BM + wc * 32 + 8 * fq;
#pragma unroll
        for (int ai = 0; ai < 2; ++ai)
#pragma unroll
            for (int m = 0; m < 4; ++m) { bf16_t* rowp = O + (size_t)(row0 + ai * HALF + m * 16) * ldc + col0;
                const float scale = ssq ? scale0 * __builtin_amdgcn_rsqf(ssq[row0 + ai * HALF + m * 16] * (1.0f / 4096.0f) + 1e-6f) : scale0;
#pragma unroll
                for (int bj = 0; bj < 2; ++bj) { const f32x4 v0 = acc[ai][bj][m][0] * scale, v1 = acc[ai][bj][m][1] * scale;
                    u32x4 w; w.x = cvt_pk_bf16(v0[0], v0[1]); w.y = cvt_pk_bf16(v0[2], v0[3]); w.z = cvt_pk_bf16(v1[0], v1[1]); w.w = cvt_pk_bf16(v1[2], v1[3]);
                    *(u32x4*)(rowp + bj * HALF) = w; } }
    }
};
struct EpiResF32 {
    static constexpr bool PERM = false, AFTER_DRAIN = false;
    const float* base0; const float* base1; int split_pm; float* out; int ldc;
    __device__ __forceinline__ void operator()(const f32x4 (&acc)[2][2][4][2], const Unit& u, int wr, int wc, int fr, int fq) const {
        const int rowl = wr * 64 + fr, col0 = u.pn * BM + wc * 32 + 4 * fq;
        const float* bp = (u.pm < split_pm) ? base0 + (size_t)u.pm * BM * ldc : base1 + (size_t)(u.pm - split_pm) * BM * ldc;
        float* op = out + (size_t)u.pm * BM * ldc;
#pragma unroll
        for (int ai = 0; ai < 2; ++ai)
#pragma unroll
            for (int m = 0; m < 4; ++m) { const size_t off = (size_t)(rowl + ai * HALF + m * 16) * ldc + col0;
#pragma unroll
                for (int bj = 0; bj < 2; ++bj)
#pragma unroll
                    for (int n = 0; n < 2; ++n) { const f32x4 b = *(const f32x4*)(bp + off + bj * HALF + n * 16); *(f32x4*)(op + off + bj * HALF + n * 16) = b + acc[ai][bj][m][n]; } }
    }
};

struct EpiResNorm {
    static constexpr bool PERM = true, AFTER_DRAIN = false;
    const float* base0; const float* base1; int split_pm; float* out; int ldc; bf16_t* hn; const float* g; float* ssq;
    __device__ __forceinline__ void operator()(const f32x4 (&acc)[2][2][4][2], const Unit& u, int wr, int wc, int fr_, int fq_) const {
        int fr = fr_, fq = fq_; asm volatile("" : "+v"(fr), "+v"(fq));
        const int rowl = wr * 64 + fr, col0 = u.pn * BM + wc * 32 + 8 * fq;
        const float* bp = (u.pm < split_pm) ? base0 + (size_t)u.pm * BM * ldc : base1 + (size_t)(u.pm - split_pm) * BM * ldc;
        float* op = out + (size_t)u.pm * BM * ldc;
        f32x4 gv[2][2];
#pragma unroll
        for (int bj = 0; bj < 2; ++bj)
#pragma unroll
            for (int n = 0; n < 2; ++n) gv[bj][n] = hn ? *(const f32x4*)(g + col0 + bj * HALF + 4 * n) : (f32x4){0.f, 0.f, 0.f, 0.f};
#pragma unroll
        for (int ai = 0; ai < 2; ++ai)
#pragma unroll
            for (int m = 0; m < 4; ++m) { const int r = rowl + ai * HALF + m * 16; const size_t off = (size_t)r * ldc + col0; float sq = 0.f;
#pragma unroll
                for (int bj = 0; bj < 2; ++bj) {
                    const f32x4 x0 = *(const f32x4*)(bp + off + bj * HALF) + acc[ai][bj][m][0], x1 = *(const f32x4*)(bp + off + bj * HALF + 4) + acc[ai][bj][m][1];
                    *(f32x4*)(op + off + bj * HALF) = x0; *(f32x4*)(op + off + bj * HALF + 4) = x1;
                    sq += (x0[0] * x0[0] + x0[1] * x0[1]) + (x0[2] * x0[2] + x0[3] * x0[3]) + (x1[0] * x1[0] + x1[1] * x1[1]) + (x1[2] * x1[2] + x1[3] * x1[3]);
                    if (hn) { const f32x4 h0 = x0 * gv[bj][0], h1 = x1 * gv[bj][1];
                        u32x4 w; w.x = cvt_pk_bf16(h0[0], h0[1]); w.y = cvt_pk_bf16(h0[2], h0[3]); w.z = cvt_pk_bf16(h1[0], h1[1]); w.w = cvt_pk_bf16(h1[2], h1[3]);
                        *(u32x4*)(hn + (size_t)u.pm * BM * ldc + off + bj * HALF) = w; } }
                sq += __shfl_xor(sq, 16); sq += __shfl_xor(sq, 32);
                if (fq == 0) __hip_atomic_fetch_add(ssq + (size_t)u.pm * BM + r, sq, __ATOMIC_RELAXED, __HIP_MEMORY_SCOPE_AGENT);
                asm volatile("" ::: "memory"); }
    }
};

__device__ __forceinline__ float dpp_ror1(float x) { return __builtin_bit_cast(float, __builtin_amdgcn_update_dpp(0, __builtin_bit_cast(int, x), 0x121, 0xf, 0xf, false)); }
__device__ __forceinline__ float dpp_rol1(float x) { return __builtin_bit_cast(float, __builtin_amdgcn_update_dpp(0, __builtin_bit_cast(int, x), 0x12f, 0xf, 0xf, false)); }
__device__ __forceinline__ unsigned dpp_ror1u(unsigned x) { return (unsigned)__builtin_amdgcn_update_dpp(0, (int)x, 0x121, 0xf, 0xf, false); }
__device__ __forceinline__ unsigned dpp_rol1u(unsigned x) { return (unsigned)__builtin_amdgcn_update_dpp(0, (int)x, 0x12f, 0xf, 0xf, false); }
__device__ __forceinline__ float bfsel(unsigned w, int h) { return __uint_as_float(h ? (w & 0xffff0000u) : (w << 16)); }
struct EpiConvGate {
    static constexpr bool PERM = true, AFTER_DRAIN = false;
    bf16_t* Gout; const float* ssq; const float* cw; const float* cb; float* edge; PG8_LAS float* xch; int dff;
    __device__ __forceinline__ void operator()(const f32x4 (&acc_)[2][2][4][2], const Unit& u, int wr, int wc, int fr_, int fq_) const {
        const f32x4 (&acc)[2][2][4][2] = acc_;
        int fr = fr_, fq = fq_; asm volatile("" : "+v"(fr), "+v"(fq));
        const int wave = wr * 4 + wc, lc = 32 * wc + 8 * fq, cg = u.pn * HALF + lc, cv = dff + cg;
        const int ldw = 2 * dff;
        const bool f0 = (fr == 0), f15 = (fr == 15);
        PG8_LAS float* my = xch + wave * 256 + fq * 16;
        const unsigned rowb = (unsigned)(u.pm * BM + wr * 64 + fr);
        unsigned zp[2][2][4][2][2];
#pragma unroll
        for (int ai = 0; ai < 2; ++ai)
#pragma unroll
            for (int m = 0; m < 4; ++m) {
                const float rs = __builtin_amdgcn_rsqf(ssq[rowb + (unsigned)(ai * HALF + m * 16)] * (1.0f / 4096.0f) + 1e-6f);
                f32x4 z[2][2];
#pragma unroll
                for (int bj = 0; bj < 2; ++bj)
#pragma unroll
                    for (int n = 0; n < 2; ++n) z[bj][n] = acc[ai][bj][m][n] * rs;
                if (m == 0 && f0) {
#pragma unroll
                    for (int bj = 0; bj < 2; ++bj)
#pragma unroll
                        for (int n = 0; n < 2; ++n) *(PG8_LAS f32x4*)(my + (ai * 2 + 0) * 64 + (bj * 2 + n) * 4) = z[bj][n]; }
                if (m == 3 && f15) {
#pragma unroll
                    for (int bj = 0; bj < 2; ++bj)
#pragma unroll
                        for (int n = 0; n < 2; ++n) *(PG8_LAS f32x4*)(my + (ai * 2 + 1) * 64 + (bj * 2 + n) * 4) = z[bj][n]; }
                if (ai == 0 && m == 0 && wr == 0 && fr < 2) { float* ep = edge + ((size_t)u.pm * 4 + fr) * ldw;
#pragma unroll
                    for (int n = 0; n < 2; ++n) { *(f32x4*)(ep + cg + 4 * n) = z[0][n]; *(f32x4*)(ep + cv + 4 * n) = z[1][n]; } }
                if (ai == 1 && m == 3 && wr == 1 && fr >= 14) { float* ep = edge + ((size_t)u.pm * 4 + (fr - 12)) * ldw;
#pragma unroll
                    for (int n = 0; n < 2; ++n) { *(f32x4*)(ep + cg + 4 * n) = z[0][n]; *(f32x4*)(ep + cv + 4 * n) = z[1][n]; } }
#pragma unroll
                for (int bj = 0; bj < 2; ++bj)
#pragma unroll
                    for (int n = 0; n < 2; ++n) { zp[ai][bj][m][n][0] = cvt_pk_bf16(z[bj][n][0], z[bj][n][1]); zp[ai][bj][m][n][1] = cvt_pk_bf16(z[bj][n][2], z[bj][n][3]); }
                asm volatile("" : "+v"(zp[ai][0][m][0][0]), "+v"(zp[ai][0][m][0][1]), "+v"(zp[ai][0][m][1][0]), "+v"(zp[ai][0][m][1][1]), "+v"(zp[ai][1][m][0][0]), "+v"(zp[ai][1][m][0][1]), "+v"(zp[ai][1][m][1][0]), "+v"(zp[ai][1][m][1][1]));
            }
        asm volatile("s_waitcnt lgkmcnt(0)" ::: "memory"); __builtin_amdgcn_s_barrier(); asm volatile("" ::: "memory");
#pragma unroll
        for (int n = 0; n < 2; ++n) {
#pragma unroll
            for (int ai = 0; ai < 2; ++ai) {
                asm volatile("" ::: "memory");
                f32x4 w0[2], w1[2], w2[2], bb[2], T[2], B[2];
                int tw = -1, tai = 0, bw = -1, bai = 0;
                if (wr == 1) { tw = wc; tai = ai; } else if (ai == 1) { tw = 4 + wc; tai = 0; }
                if (wr == 0) { bw = 4 + wc; bai = ai; } else if (ai == 0) { bw = wc; bai = 1; }
#pragma unroll
                for (int bj = 0; bj < 2; ++bj) { const int c = (bj ? cv : cg) + 4 * n;
                    w0[bj] = *(const f32x4*)(cw + c); w1[bj] = *(const f32x4*)(cw + ldw + c); w2[bj] = *(const f32x4*)(cw + 2 * ldw + c); bb[bj] = *(const f32x4*)(cb + c);
                    T[bj] = (tw >= 0) ? *(const PG8_LAS f32x4*)(xch + tw * 256 + fq * 16 + (tai * 2 + 1) * 64 + (bj * 2 + n) * 4) : (f32x4){0.f, 0.f, 0.f, 0.f};
                    B[bj] = (bw >= 0) ? *(const PG8_LAS f32x4*)(xch + bw * 256 + fq * 16 + (bai * 2 + 0) * 64 + (bj * 2 + n) * 4) : (f32x4){0.f, 0.f, 0.f, 0.f}; }
                unsigned gpk[4][2];
#pragma unroll
                for (int jp = 0; jp < 2; ++jp) {
                    float zc[2][2][4];
#pragma unroll
                    for (int bj = 0; bj < 2; ++bj) {
                        unsigned rw[4], lw[4];
#pragma unroll
                        for (int m = 0; m < 4; ++m) { rw[m] = dpp_ror1u(zp[ai][bj][m][n][jp]); lw[m] = dpp_rol1u(zp[ai][bj][m][n][jp]); }
#pragma unroll
                        for (int h = 0; h < 2; ++h) { const int j = 2 * jp + h;
                            const float w0a = f0 ? 0.f : w0[bj][j], w0b = f0 ? w0[bj][j] : 0.f, w2a = f15 ? 0.f : w2[bj][j], w2b = f15 ? w2[bj][j] : 0.f;
#pragma unroll
                            for (int m = 0; m < 4; ++m) { const float v = bfsel(zp[ai][bj][m][n][jp], h), r = bfsel(rw[m], h), l = bfsel(lw[m], h);
                                const float P = (m == 0) ? T[bj][j] : bfsel(rw[m - 1], h), N = (m == 3) ? B[bj][j] : bfsel(lw[m + 1], h);
                                zc[bj][h][m] = bb[bj][j] + w1[bj][j] * v + w0a * r + w0b * P + w2a * l + w2b * N; } }
                    }
#pragma unroll
                    for (int m = 0; m < 4; ++m) { float gv[2];
#pragma unroll
                        for (int h = 0; h < 2; ++h) { const float zg = zc[0][h][m]; gv[h] = zg * __builtin_amdgcn_rcpf(1.0f + __builtin_amdgcn_exp2f(-1.4426950408889634f * zg)) * zc[1][h][m]; }
                        gpk[m][jp] = cvt_pk_bf16(gv[0], gv[1]); }
                }
#pragma unroll
                for (int m = 0; m < 4; ++m) { const int R = ai * HALF + wr * 64 + m * 16 + fr;
                    if (R != 0 && R != BM - 1) { typedef unsigned u32x2v __attribute__((ext_vector_type(2))); u32x2v w; w.x = gpk[m][0]; w.y = gpk[m][1];
                        *(u32x2v*)(Gout + (size_t)(u.pm * BM + R) * dff + cg + 4 * n) = w; } }
            }
        }
    }
};

template <class Epi, class Sched, bool ALIGN_EPI = false, bool SP2 = false>
__device__ __forceinline__ void gemm_phase(PG8_LAS unsigned char* lds, const Gemm g, const Sched& S, const Epi& E) {
    int tid_ = threadIdx.x; asm volatile("" : "+v"(tid_));
    const int tid = tid_, wid = __builtin_amdgcn_readfirstlane(tid >> 6), lane = tid & 63, wr = wid >> 2, wc = wid & 3, fr = lane & 15, fq = lane >> 4;
    const int K = g.K, nt = K / BK;
    unsigned voffA[2], voffB[2];
#pragma unroll
    for (int i = 0; i < 2; ++i) { int R, C; stage_rc(tid * 16 + i * 8192, R, C); const int Rb = Epi::PERM ? ((R & ~31) + perm32(R & 31)) : R;
        voffA[i] = (unsigned)(R * K + C) * 2u; voffB[i] = (unsigned)(Rb * K + C) * 2u; }
    const size_t kstep = (size_t)(BK * 2);
    const size_t hstep = (size_t)HALF * K * 2;
    const size_t tstep = 2 * hstep;
    const unsigned ldsw = (unsigned)wid * 1024u;
    const int aoff = lds_byte(wr * 64 + fr, fq * 8), boff = lds_byte(wc * 32 + fr, fq * 8);
#define PG8_SA(b, h) (((b) * 2 + (h)) * HTB)
#define PG8_SB(b, h) ((4 + (b) * 2 + (h)) * HTB)
#define PG8_STAGE(bufoff, gbase, voff) do { _Pragma("unroll") for (int _i = 0; _i < 2; ++_i) \
        __builtin_amdgcn_global_load_lds((const unsigned*)((const char*)(gbase) + (voff)[_i]), (PG8_LAS unsigned*)(lds + (bufoff) + ldsw + _i * 8192), 16, 0, 0); } while (0)
#define PG8_LDA(dst, b, h) do { _Pragma("unroll") for (int m = 0; m < 4; ++m) _Pragma("unroll") for (int k = 0; k < 2; ++k) dst[m][k] = *(const PG8_LAS bf16x8*)(lds + PG8_SA(b, h) + aoff + m * 2048 + k * 1024); } while (0)
#define PG8_LDB(dst, b, h) do { _Pragma("unroll") for (int n = 0; n < 2; ++n) _Pragma("unroll") for (int k = 0; k < 2; ++k) dst[n][k] = *(const PG8_LAS bf16x8*)(lds + PG8_SB(b, h) + boff + n * 2048 + k * 1024); } while (0)
#define PG8_MMA(ai, bj, At, Bt) do { __builtin_amdgcn_s_setprio(1); _Pragma("unroll") for (int m = 0; m < 4; ++m) _Pragma("unroll") for (int n = 0; n < 2; ++n) _Pragma("unroll") for (int k = 0; k < 2; ++k) \
        acc[ai][bj][m][n] = __builtin_amdgcn_mfma_f32_16x16x32_bf16(Bt[n][k], At[m][k], acc[ai][bj][m][n], 0, 0, 0); __builtin_amdgcn_s_setprio(0); } while (0)
#define PG8_WAIT_V(n) asm volatile("s_waitcnt vmcnt(" #n ")" ::: "memory")
#define PG8_WAIT_L(n) asm volatile("s_waitcnt lgkmcnt(" #n ")" ::: "memory")
#define PG8_BAR __builtin_amdgcn_s_barrier()
#define PG8_SCHED __builtin_amdgcn_sched_barrier(0)
    Unit cur, nxt; int ui = 0;
    if (!S.next(0, cur)) return;
    f32x4 acc[2][2][4][2];
#pragma unroll
    for (int a = 0; a < 2; ++a)
#pragma unroll
        for (int b = 0; b < 2; ++b)
#pragma unroll
            for (int m = 0; m < 4; ++m)
#pragma unroll
                for (int n = 0; n < 2; ++n) acc[a][b][m][n] = (f32x4){0.f, 0.f, 0.f, 0.f};
    bf16x8 At[4][2], B0[2][2], B1[2][2];
    const char* cA = (const char*)g.A + (size_t)cur.pm * tstep; const char* cB = (const char*)g.Bt + (size_t)cur.pn * tstep;
    S.a_ready(cur);
    if constexpr (SP2) {
        PG8_STAGE(PG8_SB(0, 0), cB, voffB); PG8_STAGE(PG8_SB(0, 1), cB + hstep, voffB); PG8_STAGE(PG8_SA(0, 0), cA, voffA); PG8_STAGE(PG8_SA(0, 1), cA + hstep, voffA);
        if (wr == 1) PG8_BAR;
        PG8_WAIT_V(2); PG8_BAR;
        PG8_STAGE(PG8_SB(1, 0), cB + kstep, voffB); PG8_STAGE(PG8_SA(1, 0), cA + kstep, voffA); PG8_STAGE(PG8_SB(1, 1), cB + hstep + kstep, voffB);
        PG8_WAIT_V(6); PG8_BAR;
    } else {
        PG8_STAGE(PG8_SB(0, 0), cB, voffB); PG8_STAGE(PG8_SA(0, 0), cA, voffA); PG8_STAGE(PG8_SB(0, 1), cB + hstep, voffB); PG8_STAGE(PG8_SA(0, 1), cA + hstep, voffA);
        if (wr == 1) PG8_BAR;
        PG8_WAIT_V(4); PG8_BAR;
        PG8_STAGE(PG8_SB(1, 0), cB + kstep, voffB); PG8_STAGE(PG8_SA(1, 0), cA + kstep, voffA); PG8_STAGE(PG8_SB(1, 1), cB + hstep + kstep, voffB);
        PG8_WAIT_V(6); PG8_BAR;
    }
    for (;;) {
        const bool has_next = S.next(ui + 1, nxt);
        const char* nA = has_next ? (const char*)g.A + (size_t)nxt.pm * tstep : cA; const char* nB = has_next ? (const char*)g.Bt + (size_t)nxt.pn * tstep : cB;
        for (int t = 0; t < nt; t += 2) {
            const bool last = (t == nt - 2);
            const char* a1 = cA + (size_t)(t + 1) * kstep;
            const char* a2 = last ? nA : cA + (size_t)(t + 2) * kstep; const char* b2 = last ? nB : cB + (size_t)(t + 2) * kstep;
            const char* a3 = a2 + kstep; const char* b3 = b2 + kstep;
            if (last && has_next) S.a_ready(nxt);
            if constexpr (SP2) {
            PG8_LDB(B0, 0, 0); PG8_LDB(B1, 0, 1); PG8_SCHED; PG8_LDA(At, 0, 0); PG8_STAGE(PG8_SA(1, 1), a1 + hstep, voffA);
            PG8_WAIT_V(8); PG8_WAIT_L(0); PG8_BAR; PG8_MMA(0, 0, At, B0); PG8_MMA(0, 1, At, B1); PG8_BAR; PG8_SCHED;
            PG8_LDA(At, 0, 1); PG8_STAGE(PG8_SB(0, 0), b2, voffB); PG8_STAGE(PG8_SB(0, 1), b2 + hstep, voffB); PG8_STAGE(PG8_SA(0, 0), a2, voffA);
            PG8_WAIT_V(8); PG8_WAIT_L(0); PG8_BAR; PG8_MMA(1, 0, At, B0); PG8_MMA(1, 1, At, B1); PG8_BAR; PG8_SCHED;
            PG8_LDB(B0, 1, 0); PG8_LDB(B1, 1, 1); PG8_SCHED; PG8_LDA(At, 1, 0); PG8_STAGE(PG8_SA(0, 1), a2 + hstep, voffA);
            PG8_WAIT_V(8); PG8_WAIT_L(0); PG8_BAR; PG8_MMA(0, 0, At, B0); PG8_MMA(0, 1, At, B1); PG8_BAR; PG8_SCHED;
            PG8_LDA(At, 1, 1); PG8_STAGE(PG8_SB(1, 0), b3, voffB); PG8_STAGE(PG8_SB(1, 1), b3 + hstep, voffB); PG8_STAGE(PG8_SA(1, 0), a3, voffA);
            PG8_WAIT_V(8); PG8_WAIT_L(0); PG8_BAR; PG8_MMA(1, 0, At, B0); PG8_MMA(1, 1, At, B1); PG8_BAR; PG8_SCHED;
            } else {
            PG8_LDB(B0, 0, 0); PG8_SCHED; PG8_LDA(At, 0, 0); PG8_STAGE(PG8_SA(1, 1), a1 + hstep, voffA);
            PG8_WAIT_L(8); PG8_BAR; PG8_WAIT_L(0); PG8_MMA(0, 0, At, B0); PG8_BAR; PG8_SCHED;
            PG8_LDB(B1, 0, 1); PG8_STAGE(PG8_SB(0, 0), b2, voffB);
            PG8_BAR; PG8_WAIT_L(0); PG8_MMA(0, 1, At, B1); PG8_BAR;
            PG8_LDA(At, 0, 1); PG8_STAGE(PG8_SA(0, 0), a2, voffA);
            PG8_BAR; PG8_WAIT_L(0); PG8_MMA(1, 0, At, B0); PG8_BAR; PG8_SCHED;
            PG8_STAGE(PG8_SB(0, 1), b2 + hstep, voffB);
            PG8_WAIT_V(6); PG8_BAR; PG8_MMA(1, 1, At, B1); PG8_BAR;
            PG8_LDB(B0, 1, 0); PG8_SCHED; PG8_LDA(At, 1, 0); PG8_STAGE(PG8_SA(0, 1), a2 + hstep, voffA);
            PG8_WAIT_L(8); PG8_BAR; PG8_WAIT_L(0); PG8_MMA(0, 0, At, B0); PG8_BAR; PG8_SCHED;
            PG8_LDB(B1, 1, 1); PG8_STAGE(PG8_SB(1, 0), b3, voffB);
            PG8_BAR; PG8_WAIT_L(0); PG8_MMA(0, 1, At, B1); PG8_BAR;
            PG8_LDA(At, 1, 1); PG8_STAGE(PG8_SA(1, 0), a3, voffA);
            PG8_BAR; PG8_WAIT_L(0); PG8_MMA(1, 0, At, B0); PG8_BAR; PG8_SCHED;
            PG8_STAGE(PG8_SB(1, 1), b3 + hstep, voffB);
            PG8_WAIT_V(6); PG8_BAR; PG8_MMA(1, 1, At, B1); PG8_BAR;
            }
        }
        if constexpr (ALIGN_EPI) { if (wr == 0) PG8_BAR; }
        if constexpr (!Epi::AFTER_DRAIN) { E(acc, cur, wr, wc, fr, fq); S.done(cur); }
        if (!has_next) break;
#pragma unroll
        for (int a = 0; a < 2; ++a)
#pragma unroll
            for (int b = 0; b < 2; ++b)
#pragma unroll
                for (int m = 0; m < 4; ++m)
#pragma unroll
                    for (int n = 0; n < 2; ++n) acc[a][b][m][n] = (f32x4){0.f, 0.f, 0.f, 0.f};
        cur = nxt; cA = nA; cB = nB; ++ui;
        if constexpr (ALIGN_EPI) { if (wr == 1) PG8_BAR; }
    }
    PG8_WAIT_V(0);
    if constexpr (!ALIGN_EPI) { if (wr == 0) PG8_BAR; }
    PG8_BAR;
    if constexpr (Epi::AFTER_DRAIN) { E.fused(acc, cur, wr, wc, fr, fq, lds, wid, lane); S.done(cur); }
#undef PG8_SA
#undef PG8_SB
#undef PG8_STAGE
#undef PG8_LDA
#undef PG8_LDB
#undef PG8_MMA
#undef PG8_WAIT_V
#undef PG8_WAIT_L
#undef PG8_BAR
#undef PG8_SCHED
}
}

constexpr int NWAVES = 8;
constexpr int DM = 4096, MTOK = 32768, MPROMPT = 16384, SEQ_S = 2048;
constexpr int HD = 128, NHEAD = 16, AWID = 2048, BWID = 2048, INW = 10240, NMEMROWS = 2304, XW = 512, XHEADS = 4, DFF = 11008;
constexpr int QOFF = 4096, KOFF = 6144, VOFF = 8192;
constexpr float EPS = 1e-6f;
constexpr float LOG2E = 1.4426950408889634f;
constexpr float QSCALE = 0.08838834764831845f * LOG2E;

constexpr size_t MiB = 1u << 20;
constexpr size_t WS_CTL = 0, CTL_ZERO_BYTES = 1 * MiB;
constexpr size_t WS_SGW = 1 * MiB;
constexpr size_t WS_WIN = 2 * MiB, WS_WOUT = 82 * MiB, WS_WXQ = 114 * MiB, WS_WXKV = 118 * MiB, WS_WXO = 126 * MiB, WS_WUP = 130 * MiB, WS_WDN = 302 * MiB;
constexpr size_t WS_HN = 388 * MiB;
constexpr size_t WS_PROJ = 644 * MiB;
constexpr size_t WS_MEMN = 1284 * MiB;
constexpr size_t WS_KVX = 1302 * MiB;
constexpr size_t WS_END = 1332 * MiB;
constexpr size_t PJ_QX = 0, PJ_OX = 32 * MiB, PJ_H2 = 64 * MiB;
constexpr size_t WS_EDGE = WS_WIN;
constexpr size_t OUT_OP = 0, OP_STRIDE = 128 * MiB, OUT_LSE = 384 * MiB;
constexpr int CW_BAR = 4096;
constexpr int CW_SSQ1 = 16384, CW_SSQ2 = CW_SSQ1 + MTOK, CW_SSQ3 = CW_SSQ2 + MTOK;
static_assert((CW_SSQ3 + MTOK) * 4 <= (int)CTL_ZERO_BYTES, "CTL words inside the memset region");

constexpr int RING_OFF = 0, RING_BYTES = 131072;
constexpr int LDSCTL_OFF = RING_BYTES, MISC_OFF = LDSCTL_OFF + 320;
constexpr int LDS_BYTES = 147456;
constexpr int XCH_OFF = 133120;
constexpr int IMG_PITCH = 320;

#define GAS __attribute__((address_space(1)))
#define LAS __attribute__((address_space(3)))
typedef unsigned short bf16;
typedef unsigned v4u __attribute__((ext_vector_type(4)));
typedef unsigned v2u __attribute__((ext_vector_type(2)));
typedef float f32x4 __attribute__((ext_vector_type(4)));
typedef float f32x16 __attribute__((ext_vector_type(16)));
typedef short bf16x8 __attribute__((ext_vector_type(8)));
typedef short s16x4 __attribute__((ext_vector_type(4)));
typedef GAS unsigned gu32;
#define RLX_AGENT __ATOMIC_RELAXED, __HIP_MEMORY_SCOPE_AGENT
#define LDS_WAIT() asm volatile("s_waitcnt lgkmcnt(0)" ::: "memory")
#define VM_WAIT() asm volatile("s_waitcnt vmcnt(0)" ::: "memory")
#define SBAR() __builtin_amdgcn_sched_barrier(0)
__device__ __forceinline__ unsigned pk2(float lo, float hi) { return pg8::cvt_pk_bf16(lo, hi); }
__device__ __forceinline__ float bflo(unsigned w) { return __uint_as_float(w << 16); }
__device__ __forceinline__ float bfhi(unsigned w) { return __uint_as_float(w & 0xffff0000u); }

#define XB_TMO      128
#define XB_XCNT(j)  (256  + 64 * (j))
#define XB_XSUB(j)  (1280 + 64 * (j))
#define XB_XGEN(j)  (2304 + 64 * (j))
#define XB_TOP      3328
#define XB_TOPGEN   3392
#define XCD_BAR_WORDS 3456
#define XB_SPIN_CAP (1u << 23)

__device__ __forceinline__ unsigned xb_ld(unsigned* p)              { return __hip_atomic_load(p, __ATOMIC_RELAXED, __HIP_MEMORY_SCOPE_AGENT); }
__device__ __forceinline__ unsigned xb_add(unsigned* p, unsigned v) { return __hip_atomic_fetch_add(p, v, __ATOMIC_RELAXED, __HIP_MEMORY_SCOPE_AGENT); }
__device__ __forceinline__ unsigned xb_xcc_id() { return (unsigned)__builtin_amdgcn_s_getreg((3 << 11) | 20) & 0xFu; }
#define XB_SPIN(cond, bar) do { unsigned _sp = 0; while (cond) { __builtin_amdgcn_s_sleep(1); \
    if ((++_sp & 255u) == 0u) { if (xb_ld(&(bar)[XB_TMO])) break; if (_sp > XB_SPIN_CAP) { atomicAdd(&(bar)[XB_TMO], 1u); break; } } } } while (0)

struct XcdBarrier { unsigned* bar; unsigned x; volatile LAS unsigned* st; };

__device__ __forceinline__ XcdBarrier xcd_barrier_post(unsigned* bar, volatile LAS unsigned* st) {
    XcdBarrier b; b.bar = bar; b.x = xb_xcc_id(); b.st = st;
    if (threadIdx.x == 0) (void)xb_add(&bar[XB_XCNT(b.x)], 1u);
    return b;
}
__device__ __forceinline__ void xcd_barrier_complete(unsigned* bar, unsigned x, unsigned& nloc, unsigned& nx) {
    const unsigned G = gridDim.x * gridDim.y * gridDim.z;
    unsigned sum, cnt, mine, sp = 0u;
    for (;;) {
        sum = 0u; cnt = 0u; mine = 0u;
#pragma unroll
        for (unsigned j = 0; j < 16; ++j) { const unsigned c = xb_ld(&bar[XB_XCNT(j)]); sum += c; cnt += (c > 0u) ? 1u : 0u; mine = (j == x) ? c : mine; }
        if (sum == G) break;
        __builtin_amdgcn_s_sleep(1);
        if ((++sp & 255u) == 0u) { if (xb_ld(&bar[XB_TMO])) break; if (sp > XB_SPIN_CAP) { atomicAdd(&bar[XB_TMO], 1u); break; } }
    }
    nloc = mine > 0u ? mine : 1u; nx = cnt > 0u ? cnt : 1u;
}
__device__ __forceinline__ void xcd_barrier(const XcdBarrier& b) {
    asm volatile("s_waitcnt vmcnt(0)" ::: "memory");
    __syncthreads();
    if (threadIdx.x == 0) {
        unsigned* bar = b.bar;
        __builtin_amdgcn_s_waitcnt(0);
        unsigned nloc = b.st[0], nx = b.st[1];
        if (nloc == 0u) { xcd_barrier_complete(bar, b.x, nloc, nx); b.st[0] = nloc; b.st[1] = nx; }
        const unsigned old = xb_add(&bar[XB_XSUB(b.x)], 1u);
        const unsigned gen = old / nloc;
        if (old + 1u == (gen + 1u) * nloc) {
            __builtin_amdgcn_fence(__ATOMIC_RELEASE, "agent");
            asm volatile("s_waitcnt vmcnt(0)" ::: "memory");
            const unsigned og = xb_add(&bar[XB_TOP], 1u);
            const unsigned tg = og / nx;
            if (og + 1u == (tg + 1u) * nx) xb_add(&bar[XB_TOPGEN], 1u);
            else XB_SPIN(xb_ld(&bar[XB_TOPGEN]) == tg, bar);
            __builtin_amdgcn_fence(__ATOMIC_ACQUIRE, "agent");
            xb_add(&bar[XB_XGEN(b.x)], 1u);
            asm volatile("s_waitcnt vmcnt(0)" ::: "memory");
        } else {
            XB_SPIN(xb_ld(&bar[XB_XGEN(b.x)]) == gen, bar);
            __builtin_amdgcn_fence(__ATOMIC_ACQUIRE, "agent");
            asm volatile("s_waitcnt vmcnt(0)" ::: "memory");
        }
    }
    __syncthreads();
}

__device__ __forceinline__ float wave_sum(float v) {
#pragma unroll
    for (int o = 1; o < 64; o <<= 1) v += __shfl_xor(v, o);
    return v;
}
__device__ __forceinline__ float half_swap_sum(float v) { const auto rr = __builtin_amdgcn_permlane32_swap(__float_as_uint(v), __float_as_uint(v), false, false); return __uint_as_float(rr[0]) + __uint_as_float(rr[1]); }
__device__ __forceinline__ float half_swap_max(float v) { const auto rr = __builtin_amdgcn_permlane32_swap(__float_as_uint(v), __float_as_uint(v), false, false); return fmaxf(__uint_as_float(rr[0]), __uint_as_float(rr[1])); }
__device__ __forceinline__ int crow(int r, int hi) { return (r & 3) + 8 * (r >> 2) + 4 * hi; }
__device__ __forceinline__ s16x4 tr_read(unsigned addr) { s16x4 r; asm volatile("ds_read_b64_tr_b16 %0, %1" : "=&v"(r) : "v"(addr) : "memory"); return r; }
#define PK8(L, H) (bf16x8){L[0], L[1], L[2], L[3], H[0], H[1], H[2], H[3]}

template <bool GATEMAP = false>
__device__ __forceinline__ void p0_transpose_item(const float* W, int K, int N, bf16* WT, LAS float* scr, int item, int lane) {
    const int nblk = N / 32, kb = item / nblk, nb = item % nblk, k0 = 64 * kb, n0 = 32 * nb;
    const int r0 = GATEMAP ? ((n0 < N / 2) ? 256 * (n0 / 128) + (n0 % 128) : 256 * ((n0 - N / 2) / 128) + 128 + ((n0 - N / 2) % 128)) : n0;
#pragma unroll 8
    for (int i = 0; i < 32; ++i) { const int kk = 2 * i + (lane >> 5); scr[kk * 33 + (lane & 31)] = W[(size_t)(k0 + kk) * N + n0 + (lane & 31)]; }
    LDS_WAIT(); asm volatile("" ::: "memory");
    const int c = lane & 7;
#pragma unroll
    for (int j = 0; j < 4; ++j) { const int n = (lane >> 3) + 8 * j; const LAS float* s = scr + (8 * c) * 33 + n;
        v4u o; o.x = pk2(s[0 * 33], s[1 * 33]); o.y = pk2(s[2 * 33], s[3 * 33]); o.z = pk2(s[4 * 33], s[5 * 33]); o.w = pk2(s[6 * 33], s[7 * 33]);
        *(GAS v4u*)(WT + (size_t)(r0 + n) * K + k0 + 8 * c) = o; }
    LDS_WAIT(); asm volatile("" ::: "memory");
}
__device__ __forceinline__ void rms_row_to_bf16(const float* xrow, const float* g, bf16* orow, int lane) {
    const GAS f32x4* xr = (const GAS f32x4*)xrow + lane; const GAS f32x4* gr = (const GAS f32x4*)g + lane;
    f32x4 v[16]; float s = 0.f;
#pragma unroll
    for (int j = 0; j < 16; ++j) { v[j] = xr[64 * j]; s += (v[j].x * v[j].x + v[j].y * v[j].y) + (v[j].z * v[j].z + v[j].w * v[j].w); }
    const float rstd = 1.0f / sqrtf(wave_sum(s) * (1.f / DM) + EPS);
    GAS v2u* o8 = (GAS v2u*)orow + lane;
#pragma unroll
    for (int j = 0; j < 16; ++j) { const f32x4 gg = gr[64 * j]; v2u w; w.x = pk2(v[j].x * rstd * gg.x, v[j].y * rstd * gg.y); w.y = pk2(v[j].z * rstd * gg.z, v[j].w * rstd * gg.w); o8[64 * j] = w; }
}
__device__ __forceinline__ void rms_row_inplace(float* xrow, const float* g, int lane) {
    GAS f32x4* xr = (GAS f32x4*)xrow + lane; const GAS f32x4* gr = (const GAS f32x4*)g + lane;
    f32x4 v[16]; float s = 0.f;
#pragma unroll
    for (int j = 0; j < 16; ++j) { v[j] = xr[64 * j]; s += (v[j].x * v[j].x + v[j].y * v[j].y) + (v[j].z * v[j].z + v[j].w * v[j].w); }
    const float rstd = 1.0f / sqrtf(wave_sum(s) * (1.f / DM) + EPS);
#pragma unroll
    for (int j = 0; j < 16; ++j) { const f32x4 gg = gr[64 * j]; xr[64 * j] = v[j] * rstd * gg; }
}

__device__ __forceinline__ void v_dma_issue(const bf16* vp, size_t vstride4, LAS unsigned char* buf) {
#pragma unroll
    for (int i = 0; i < 8; ++i) __builtin_amdgcn_global_load_lds((const unsigned*)(vp + (size_t)i * vstride4), (LAS unsigned*)(buf + i * 1024), 16, 0, 0);
}
__device__ __forceinline__ void k_load_issue(bf16x8 (&kf)[8], const bf16* kp) {
#define KLD(i) asm volatile("global_load_dwordx4 %0, %1, off offset:" #i : "=v"(kf[(i) / 32]) : "v"(kp) : "memory")
    KLD(0); KLD(32); KLD(64); KLD(96); KLD(128); KLD(160); KLD(192); KLD(224);
#undef KLD
}
template <bool DIL, bool LAST>
__device__ __forceinline__ void attn_tile(f32x16 (&o)[4], float& m, float& l, const bf16x8 (&qf)[8], bf16x8 (&kf)[8], const bf16* kp_next, unsigned vaddr, const unsigned (&xq)[4], float slope2d, int lane, int kt, bool valid) {
    const int c = lane & 31, hi = lane >> 5;
    SBAR();
    if (LAST) asm volatile("s_waitcnt vmcnt(0)" : "+v"(kf[0]), "+v"(kf[1]), "+v"(kf[2]), "+v"(kf[3]), "+v"(kf[4]), "+v"(kf[5]), "+v"(kf[6]), "+v"(kf[7]) :: "memory");
    else asm volatile("s_waitcnt vmcnt(8)" : "+v"(kf[0]), "+v"(kf[1]), "+v"(kf[2]), "+v"(kf[3]), "+v"(kf[4]), "+v"(kf[5]), "+v"(kf[6]), "+v"(kf[7]) :: "memory");
    f32x16 s;
#pragma unroll
    for (int i = 0; i < 16; ++i) s[i] = 0.f;
#pragma unroll
    for (int ks = 0; ks < 8; ++ks) s = __builtin_amdgcn_mfma_f32_32x32x16_bf16(kf[ks], qf[ks], s, 0, 0, 0);
    SBAR();
    if (!LAST) { k_load_issue(kf, kp_next); SBAR(); }
    if (DIL) {
        const int dbase = 32 * kt + 4 * hi - c;
#pragma unroll
        for (int i = 0; i < 16; ++i) { const int diff = dbase + crow(i, 0); const int adi = diff < 0 ? -diff : diff;
            const float v = s[i] - slope2d * (float)adi;
            s[i] = (adi <= 64 && valid) ? v : -1e30f; }
    }
    float mx = s[0];
#pragma unroll
    for (int i = 1; i < 16; ++i) mx = fmaxf(mx, s[i]);
    mx = half_swap_max(mx);
    const float mn = fmaxf(m, mx), alpha = __builtin_amdgcn_exp2f(m - mn);
    float ps = 0.f;
#pragma unroll
    for (int i = 0; i < 16; ++i) { s[i] = __builtin_amdgcn_exp2f(s[i] - mn); ps += s[i]; }
    ps = half_swap_sum(ps);
    l = l * alpha + ps; m = mn;
#pragma unroll
    for (int d = 0; d < 4; ++d)
#pragma unroll
        for (int i = 0; i < 16; ++i) o[d][i] *= alpha;
    v4u w0, w1;
    w0.x = pk2(s[0], s[1]); w0.y = pk2(s[2], s[3]); w0.z = pk2(s[4], s[5]); w0.w = pk2(s[6], s[7]);
    w1.x = pk2(s[8], s[9]); w1.y = pk2(s[10], s[11]); w1.z = pk2(s[12], s[13]); w1.w = pk2(s[14], s[15]);
    const bf16x8 pb0 = __builtin_bit_cast(bf16x8, w0), pb1 = __builtin_bit_cast(bf16x8, w1);
    if (LAST) asm volatile("s_waitcnt vmcnt(0)" ::: "memory"); else asm volatile("s_waitcnt vmcnt(16)" ::: "memory");
    SBAR();
#pragma unroll
    for (int s2 = 0; s2 < 2; ++s2) {
        s16x4 a[4][2];
#pragma unroll
        for (int d = 0; d < 4; ++d)
#pragma unroll
            for (int t = 0; t < 2; ++t) a[d][t] = tr_read(vaddr + (unsigned)((4 * s2 + 2 * t) * 1024) + xq[d]);
        LDS_WAIT(); SBAR();
#pragma unroll
        for (int d = 0; d < 4; ++d) o[d] = __builtin_amdgcn_mfma_f32_32x32x16_bf16(PK8(a[d][0], a[d][1]), s2 ? pb1 : pb0, o[d], 0, 0, 0);
    }
    SBAR();
}

__device__ __forceinline__ void attn_tile_lds(f32x16 (&o)[4], float& m, float& l, const bf16x8 (&qf)[8], const LAS unsigned char* kbuf, unsigned vaddr, const unsigned (&xq)[4], float slope2d, int lane, int kt) {
    const int c = lane & 31, hi = lane >> 5;
    SBAR();
    bf16x8 kf[8];
    const LAS unsigned char* krow = kbuf + c * 256;
#pragma unroll
    for (int ks = 0; ks < 8; ++ks) kf[ks] = *(const LAS bf16x8*)(krow + 16 * ((2 * ks + hi) ^ (c & 15)));
    f32x16 s;
#pragma unroll
    for (int i = 0; i < 16; ++i) s[i] = 0.f;
#pragma unroll
    for (int ks = 0; ks < 8; ++ks) s = __builtin_amdgcn_mfma_f32_32x32x16_bf16(kf[ks], qf[ks], s, 0, 0, 0);
    { const int dbase = 32 * kt + 4 * hi - c;
#pragma unroll
      for (int i = 0; i < 16; ++i) { const int diff = dbase + crow(i, 0); const int adi = diff < 0 ? -diff : diff;
          const float v = s[i] - slope2d * (float)adi;
          s[i] = (adi <= 64) ? v : -1e30f; } }
    float mx = s[0];
#pragma unroll
    for (int i = 1; i < 16; ++i) mx = fmaxf(mx, s[i]);
    mx = half_swap_max(mx);
    const float mn = fmaxf(m, mx), alpha = __builtin_amdgcn_exp2f(m - mn);
    float ps = 0.f;
#pragma unroll
    for (int i = 0; i < 16; ++i) { s[i] = __builtin_amdgcn_exp2f(s[i] - mn); ps += s[i]; }
    ps = half_swap_sum(ps);
    l = l * alpha + ps; m = mn;
#pragma unroll
    for (int d = 0; d < 4; ++d)
#pragma unroll
        for (int i = 0; i < 16; ++i) o[d][i] *= alpha;
    v4u w0, w1;
    w0.x = pk2(s[0], s[1]); w0.y = pk2(s[2], s[3]); w0.z = pk2(s[4], s[5]); w0.w = pk2(s[6], s[7]);
    w1.x = pk2(s[8], s[9]); w1.y = pk2(s[10], s[11]); w1.z = pk2(s[12], s[13]); w1.w = pk2(s[14], s[15]);
    const bf16x8 pb0 = __builtin_bit_cast(bf16x8, w0), pb1 = __builtin_bit_cast(bf16x8, w1);
    SBAR();
#pragma unroll
    for (int s2 = 0; s2 < 2; ++s2) {
        s16x4 a[4][2];
#pragma unroll
        for (int d = 0; d < 4; ++d)
#pragma unroll
            for (int t = 0; t < 2; ++t) a[d][t] = tr_read(vaddr + (unsigned)((4 * s2 + 2 * t) * 1024) + xq[d]);
        LDS_WAIT(); SBAR();
#pragma unroll
        for (int d = 0; d < 4; ++d) o[d] = __builtin_amdgcn_mfma_f32_32x32x16_bf16(PK8(a[d][0], a[d][1]), s2 ? pb1 : pb0, o[d], 0, 0, 0);
    }
    SBAR();
}

__device__ __forceinline__ void attn_store(const f32x16 (&o)[4], float l, bf16* orow, int hi) {
    const float inv = 1.0f / l;
#pragma unroll
    for (int d = 0; d < 4; ++d)
#pragma unroll
        for (int g4 = 0; g4 < 4; ++g4) { v2u w; w.x = pk2(o[d][4 * g4] * inv, o[d][4 * g4 + 1] * inv); w.y = pk2(o[d][4 * g4 + 2] * inv, o[d][4 * g4 + 3] * inv);
            *(GAS v2u*)(orow + 32 * d + 8 * g4 + 4 * hi) = w; }
}

struct Args { const float* in[24]; float* out; unsigned char* ws; int ph_lo, ph_hi; };
enum { I_XP = 0, I_XS, I_MEMP, I_MEMS, I_NMIXG, I_WIN, I_SGLNG, I_SGLNB, I_SGW, I_SGB, I_GAG, I_GBG, I_WOUT, I_NXG, I_MEMG, I_WXQ, I_WXKV, I_WXO, I_NFFNG, I_WUP, I_CONVW, I_CONVB, I_WDN, I_FING };

__global__ void __launch_bounds__(NWAVES * 64, 2) fwd_kernel(Args args) {
    extern __shared__ __attribute__((aligned(16))) unsigned char lds_raw[];
    LAS unsigned char* lds = (LAS unsigned char*)lds_raw;
    volatile LAS unsigned* MISC = (volatile LAS unsigned*)(lds + MISC_OFF);
    const int tid = threadIdx.x, lane = tid & 63, wave = __builtin_amdgcn_readfirstlane(tid >> 6);
    const int G = gridDim.x, gw = blockIdx.x * NWAVES + wave, NGW = G * NWAVES;
    unsigned char* ws = args.ws;
    gu32* ctl = (gu32*)(ws + WS_CTL);
    bf16* SGWB = (bf16*)(ws + WS_SGW);
    bf16* Win_t = (bf16*)(ws + WS_WIN); bf16* Wout_t = (bf16*)(ws + WS_WOUT); bf16* Wxq_t = (bf16*)(ws + WS_WXQ); bf16* Wxkv_t = (bf16*)(ws + WS_WXKV);
    bf16* Wxo_t = (bf16*)(ws + WS_WXO); bf16* Wup_t = (bf16*)(ws + WS_WUP); bf16* Wdn_t = (bf16*)(ws + WS_WDN);
    bf16* HN = (bf16*)(ws + WS_HN); bf16* UVB = (bf16*)(ws + WS_PROJ); bf16* QKVB = (bf16*)(ws + WS_PROJ + 256 * MiB);
    bf16* MEMN = (bf16*)(ws + WS_MEMN); bf16* KVX = (bf16*)(ws + WS_KVX);
    bf16* QX = (bf16*)(ws + WS_PROJ + PJ_QX); bf16* OX = (bf16*)(ws + WS_PROJ + PJ_OX); bf16* GB = (bf16*)(ws + WS_PROJ); float* EDGE = (float*)(ws + WS_EDGE);
    float* OUT = args.out;
    unsigned char* outb = (unsigned char*)args.out;
    float* LSE = (float*)(outb + OUT_LSE);
    bf16* H2 = (bf16*)(ws + WS_PROJ + PJ_H2);
    float* SSQ1 = (float*)(ws + WS_CTL) + CW_SSQ1; float* SSQ2 = (float*)(ws + WS_CTL) + CW_SSQ2; float* SSQ3 = (float*)(ws + WS_CTL) + CW_SSQ3;

    for (int u = tid; u < (LDS_BYTES - LDSCTL_OFF) / 4; u += NWAVES * 64) ((LAS unsigned*)(lds + LDSCTL_OFF))[u] = 0u;
    __syncthreads();
    XcdBarrier bar = xcd_barrier_post((unsigned*)(ctl + CW_BAR), MISC + 8);
#define GRID_BAR() xcd_barrier(bar)
    const int lo = args.ph_lo, hi_ph = args.ph_hi;
#ifdef PHMASK
#define IN(k) ((PHMASK >> (k)) & 1)
#else
#define IN(k) (lo <= (k) && (k) < hi_ph)
#endif

    if (IN(0)) {
        LAS float* scr = (LAS float*)(lds + RING_OFF + wave * 16384);
        constexpr int I_1 = (DM / 64) * (INW / 32), I_2 = (DM / 64) * (DM / 32), I_3 = (DM / 64) * (XW / 32), I_4 = (DM / 64) * (2 * XW / 32), I_5 = (XW / 64) * (DM / 32),
                      I_6 = (DM / 64) * (2 * DFF / 32), I_7 = (DFF / 64) * (DM / 32);
        constexpr int NITEMS = I_1 + I_2 + I_3 + I_4 + I_5 + I_6 + I_7;
        for (int it = gw; it < NITEMS; it += NGW) {
            int r = it;
            if (r < I_1) { p0_transpose_item(args.in[I_WIN], DM, INW, Win_t, scr, r, lane); continue; } r -= I_1;
            if (r < I_2) { p0_transpose_item(args.in[I_WOUT], DM, DM, Wout_t, scr, r, lane); continue; } r -= I_2;
            if (r < I_3) { p0_transpose_item(args.in[I_WXQ], DM, XW, Wxq_t, scr, r, lane); continue; } r -= I_3;
            if (r < I_4) { p0_transpose_item(args.in[I_WXKV], DM, 2 * XW, Wxkv_t, scr, r, lane); continue; } r -= I_4;
            if (r < I_5) { p0_transpose_item(args.in[I_WXO], XW, DM, Wxo_t, scr, r, lane); continue; } r -= I_5;
            if (r < I_6) { p0_transpose_item<true>(args.in[I_WUP], DM, 2 * DFF, Wup_t, scr, r, lane); continue; } r -= I_6;
            p0_transpose_item(args.in[I_WDN], DFF, DM, Wdn_t, scr, r, lane);
        }
        for (int i = blockIdx.x * 512 + tid; i < NHEAD * 128 * 128 / 2; i += G * 512) { const float2 v = ((const float2*)args.in[I_SGW])[i]; ((unsigned*)SGWB)[i] = pk2(v.x, v.y); }
        for (int mrow = gw; mrow < MTOK; mrow += NGW) {
            const float* xr = mrow < MPROMPT ? args.in[I_XP] + (size_t)mrow * DM : args.in[I_XS] + (size_t)(mrow - MPROMPT) * DM;
            rms_row_to_bf16(xr, args.in[I_NMIXG], HN + (size_t)mrow * DM, lane); }
        for (int mrow = gw; mrow < NMEMROWS; mrow += NGW) {
            const float* xr = mrow < 256 ? args.in[I_MEMP] + (size_t)mrow * DM : args.in[I_MEMS] + (size_t)(mrow - 256) * DM;
            rms_row_to_bf16(xr, args.in[I_MEMG], MEMN + (size_t)mrow * DM, lane); }
        GRID_BAR();
    }

    if (IN(1)) {
        { pg8::Gemm g{HN, Win_t, MTOK, INW, DM}; pg8::StaticOrder S; S.init(MTOK, INW, G, (int)blockIdx.x);
          pg8::EpiInProj E{UVB, QKVB, MTOK, QSCALE};
          pg8::gemm_phase<pg8::EpiInProj, pg8::StaticOrder, true, true>(lds + RING_OFF, g, S, E); }
        { pg8::Gemm g{MEMN, Wxkv_t, NMEMROWS, 2 * XW, DM}; pg8::StaticOrder S; S.init(NMEMROWS, 2 * XW, G, (int)blockIdx.x);
          pg8::EpiBf16S E{KVX, 2 * XW, 1.0f, nullptr};
          pg8::gemm_phase<pg8::EpiBf16S, pg8::StaticOrder, true, true>(lds + RING_OFF, g, S, E); }
        GRID_BAR();
    }

    if (IN(2)) {
#ifndef NO_SG
        LAS float* stat_mean = (LAS float*)(lds + 81920); LAS float* stat_rstd = stat_mean + 128; LAS float* ssqL = stat_mean + 256;
        const float* lng = args.in[I_SGLNG]; const float* lnb = args.in[I_SGLNB]; const float* sgb = args.in[I_SGB]; const float* gag = args.in[I_GAG];
        for (int ck = blockIdx.x; ck < MTOK / 128; ck += G) {
            const int R0 = ck * 128;
#pragma unroll 4
            for (int rr = 0; rr < 16; ++rr) { const int srow = wave * 16 + rr; const GAS v4u* vp = (const GAS v4u*)(UVB + (size_t)(R0 + srow) * 4096 + AWID) + lane;
                float x[32]; float sm = 0.f;
#pragma unroll
                for (int j = 0; j < 4; ++j) { const v4u w = vp[64 * j];
                    x[8 * j + 0] = bflo(w.x); x[8 * j + 1] = bfhi(w.x); x[8 * j + 2] = bflo(w.y); x[8 * j + 3] = bfhi(w.y); x[8 * j + 4] = bflo(w.z); x[8 * j + 5] = bfhi(w.z); x[8 * j + 6] = bflo(w.w); x[8 * j + 7] = bfhi(w.w); }
#pragma unroll
                for (int j = 0; j < 32; ++j) sm += x[j];
                const float mean = wave_sum(sm) * (1.f / AWID); float sq = 0.f;
#pragma unroll
                for (int j = 0; j < 32; ++j) { const float d = x[j] - mean; sq += d * d; }
                const float rstd = 1.0f / sqrtf(wave_sum(sq) * (1.f / AWID) + EPS);
                if (lane == 0) { stat_mean[srow] = mean; stat_rstd[srow] = rstd; } }
            __syncthreads();
            const int hh = wave >> 2, tb = wave & 3, c = lane & 31, hi = lane >> 5;
            float ssq = 0.f;
            for (int hp = 0; hp < 8; ++hp) {
                { const int ch32 = tid & 31, colbase = 256 * hp + 8 * ch32;
                  float gv[8], bv[8];
#pragma unroll
                  for (int j = 0; j < 8; ++j) { gv[j] = lng[colbase + j]; bv[j] = lnb[colbase + j]; }
                  LAS unsigned char* ib = lds + (ch32 >> 4) * (128 * IMG_PITCH) + 16 * (ch32 & 15);
#pragma unroll
                  for (int i = 0; i < 8; ++i) { const int srow = (tid >> 5) + 16 * i;
                      const v4u w = *(const GAS v4u*)(UVB + (size_t)(R0 + srow) * 4096 + AWID + colbase);
                      const float mu = stat_mean[srow], rs = stat_rstd[srow];
                      v4u o;
                      o.x = pk2((bflo(w.x) - mu) * rs * gv[0] + bv[0], (bfhi(w.x) - mu) * rs * gv[1] + bv[1]);
                      o.y = pk2((bflo(w.y) - mu) * rs * gv[2] + bv[2], (bfhi(w.y) - mu) * rs * gv[3] + bv[3]);
                      o.z = pk2((bflo(w.z) - mu) * rs * gv[4] + bv[4], (bfhi(w.z) - mu) * rs * gv[5] + bv[5]);
                      o.w = pk2((bflo(w.w) - mu) * rs * gv[6] + bv[6], (bfhi(w.w) - mu) * rs * gv[7] + bv[7]);
                      *(LAS v4u*)(ib + srow * IMG_PITCH) = o; } }
                __syncthreads();
                { int lz = lane; asm volatile("" : "+v"(lz)); const int c = lz & 31, hi = lz >> 5;
                  const int g = 2 * hp + hh, t = 32 * tb + c;
                  bf16x8 wf[8];
                  const bf16* wrow = SGWB + ((size_t)(g * 128 + t)) * 128 + 8 * hi;
#pragma unroll
                  for (int ks = 0; ks < 8; ++ks) wf[ks] = *(const GAS bf16x8*)(wrow + 16 * ks);
                  f32x16 acc[4];
#pragma unroll
                  for (int d = 0; d < 4; ++d)
#pragma unroll
                      for (int i = 0; i < 16; ++i) acc[d][i] = 0.f;
                  const unsigned rb = (unsigned)(uintptr_t)(lds + hh * (128 * IMG_PITCH)) + (unsigned)((8 * hi + ((lz & 15) >> 2)) * IMG_PITCH + 32 * ((lz >> 4) & 1) + 8 * (lz & 3));
#pragma unroll
                  for (int ks = 0; ks < 8; ++ks) {
                      s16x4 a[4][2];
#pragma unroll
                      for (int d = 0; d < 4; ++d)
#pragma unroll
                          for (int tt = 0; tt < 2; ++tt) a[d][tt] = tr_read(rb + (unsigned)((16 * ks + 4 * tt) * IMG_PITCH + 64 * d));
                      LDS_WAIT(); SBAR();
#pragma unroll
                      for (int d = 0; d < 4; ++d) acc[d] = __builtin_amdgcn_mfma_f32_32x32x16_bf16(PK8(a[d][0], a[d][1]), wf[ks], acc[d], 0, 0, 0);
                  }
                  const float bs = sgb[g * 128 + t];
                  const bf16* urow = UVB + (size_t)(R0 + t) * 4096 + g * 128 + 4 * hi;
                  bf16* orow = HN + (size_t)(R0 + t) * DM + g * 128 + 4 * hi;
#pragma unroll
                  for (int d = 0; d < 4; ++d)
#pragma unroll
                      for (int g4 = 0; g4 < 4; ++g4) { const v2u uu = *(const GAS v2u*)(urow + 32 * d + 8 * g4);
                          const float a0 = bflo(uu.x) * (acc[d][4 * g4] + bs), a1 = bfhi(uu.x) * (acc[d][4 * g4 + 1] + bs), a2 = bflo(uu.y) * (acc[d][4 * g4 + 2] + bs), a3 = bfhi(uu.y) * (acc[d][4 * g4 + 3] + bs);
                          ssq += (a0 * a0 + a1 * a1) + (a2 * a2 + a3 * a3);
                          v2u w; w.x = pk2(a0, a1); w.y = pk2(a2, a3); *(GAS v2u*)(orow + 32 * d + 8 * g4) = w; }
                }
                __syncthreads();
            }
            ssq = half_swap_sum(ssq);
            if (hi == 0) ssqL[hh * 128 + 32 * tb + c] = ssq;
            VM_WAIT();
            __syncthreads();
            { const int cc = tid & 255;
              float gg[8];
#pragma unroll
              for (int j = 0; j < 8; ++j) gg[j] = gag[8 * cc + j];
#pragma unroll 8
              for (int i = 0; i < 64; ++i) { const int t = (tid >> 8) + 2 * i; const float rs = 1.0f / sqrtf((ssqL[t] + ssqL[128 + t]) * (1.f / AWID) + EPS);
                  GAS v4u* p = (GAS v4u*)(HN + (size_t)(R0 + t) * DM + 8 * cc); const v4u w = *p; v4u o;
                  o.x = pk2(bflo(w.x) * rs * gg[0], bfhi(w.x) * rs * gg[1]); o.y = pk2(bflo(w.y) * rs * gg[2], bfhi(w.y) * rs * gg[3]);
                  o.z = pk2(bflo(w.z) * rs * gg[4], bfhi(w.z) * rs * gg[5]); o.w = pk2(bflo(w.w) * rs * gg[6], bfhi(w.w) * rs * gg[7]); *p = o; } }
            __syncthreads();
        }
#endif
#ifndef NO_DIL
        { LAS unsigned char* kvb = lds;
          const int c = lane & 31, hi = lane >> 5, q4 = (lane & 15) >> 2;
          const int drow = 4 * wave + (lane >> 4);
          const int kchunk = 8 * ((lane & 15) ^ (drow & 15)), vchunk = 8 * ((lane & 15) ^ ((drow & 3) << 2));
          const unsigned vrd = (unsigned)(uintptr_t)kvb + 8192u + (unsigned)(hi * 1024 + q4 * 256 + 32 * ((lane >> 4) & 1) + 8 * (lane & 3));
          unsigned xq[4];
#pragma unroll
          for (int dd = 0; dd < 4; ++dd) xq[dd] = (unsigned)(64 * (dd ^ q4));
          constexpr int NRUN = 768 + 256 + 512 + 2048;
          for (int R = blockIdx.x; R < NRUN; R += G) {
              int p, h, base, S, r, qb0, L;
              if (R < 768) { p = R >> 8; const int rem = R & 255; h = rem >> 4; const int k = rem & 15, d_ = (p == 0) ? 1 : (p == 1 ? 4 : 16), rpr = 16 / d_; base = 0; S = MPROMPT; r = k / rpr; qb0 = 32 * (k % rpr); L = 32; }
              else if (R < 1024) { const int idx = R - 768; p = 0; h = idx >> 4; const int k = idx & 15; base = MPROMPT + SEQ_S * (k >> 1); S = SEQ_S; r = 0; qb0 = 32 * (k & 1); L = 32; }
              else if (R < 1536) { const int idx = R - 1024; p = 1; h = idx >> 5; const int k = idx & 31; base = MPROMPT + SEQ_S * (k >> 2); S = SEQ_S; r = k & 3; qb0 = 0; L = 16; }
              else { const int idx = R - 1536; p = 2; h = idx >> 7; const int k = idx & 127; base = MPROMPT + SEQ_S * (k >> 4); S = SEQ_S; r = k & 15; qb0 = 0; L = 4; }
              const int d = (p == 0) ? 1 : (p == 1 ? 4 : 16);
              const int nblk = (S / d) >> 5, Tlo = (qb0 - 2 > 0) ? qb0 - 2 : 0, Thi = (qb0 + L + 1 < nblk - 1) ? qb0 + L + 1 : nblk - 1;
              const float slope2d = __builtin_amdgcn_exp2f(-0.5f * (float)(h + 1)) * LOG2E * (float)d;
              const bf16* Qh = QKVB + (size_t)(0 * NHEAD + h) * MTOK * HD; const bf16* Kh = QKVB + (size_t)(1 * NHEAD + h) * MTOK * HD; const bf16* Vh = QKVB + (size_t)(2 * NHEAD + h) * MTOK * HD;
              bf16* OPp = (bf16*)(outb + OUT_OP + (size_t)p * OP_STRIDE);
              int j = wave;
              bf16x8 qf[8]; f32x16 o[4]; float m = -1e30f, l = 0.f;
#pragma unroll
              for (int ks = 0; ks < 8; ++ks) qf[ks] = (bf16x8){0, 0, 0, 0, 0, 0, 0, 0};
#pragma unroll
              for (int dd = 0; dd < 4; ++dd)
#pragma unroll
                  for (int i = 0; i < 16; ++i) o[dd][i] = 0.f;
#pragma unroll 1
              for (int T = Tlo - 1; T <= Thi + 1; ++T) {
                  asm volatile("s_waitcnt vmcnt(0)" : "+v"(qf[0]), "+v"(qf[1]), "+v"(qf[2]), "+v"(qf[3]), "+v"(qf[4]), "+v"(qf[5]), "+v"(qf[6]), "+v"(qf[7]) :: "memory");
                  __builtin_amdgcn_s_barrier(); asm volatile("" ::: "memory");
                  if (T + 1 <= Thi) { LAS unsigned char* dst = kvb + ((T + 1) & 1) * 16384 + wave * 1024; const size_t grow = (size_t)(base + (32 * (T + 1) + drow) * d + r) * HD;
                      __builtin_amdgcn_global_load_lds((const unsigned*)(Kh + grow + kchunk), (LAS unsigned*)dst, 16, 0, 0);
                      __builtin_amdgcn_global_load_lds((const unsigned*)(Vh + grow + vchunk), (LAS unsigned*)(dst + 8192), 16, 0, 0); }
                  if (j < L) {
                      const int qb = qb0 + j, Tf = (qb - 2 > Tlo) ? qb - 2 : Tlo, Tl = (qb + 2 < Thi) ? qb + 2 : Thi;
                      const size_t rowq = (size_t)(base + (32 * qb + c) * d + r);
                      if (T == Tf - 1) { k_load_issue(qf, Qh + rowq * HD + 8 * hi);
                          m = -1e30f; l = 0.f;
#pragma unroll
                          for (int dd = 0; dd < 4; ++dd)
#pragma unroll
                              for (int i = 0; i < 16; ++i) o[dd][i] = 0.f; }
                      if (T >= Tf && T <= Tl) attn_tile_lds(o, m, l, qf, kvb + (T & 1) * 16384, vrd + (unsigned)((T & 1) * 16384), xq, slope2d, lane, T - qb);
                      if (T == Tl + 1) { attn_store(o, l, OPp + rowq * BWID + h * HD, hi);
                          if (hi == 0) LSE[((size_t)p * MTOK + rowq) * NHEAD + h] = m + __builtin_amdgcn_logf(l);
                          j += 8; }
                  }
              }
          } }
#endif
        GRID_BAR();
    }

    if (IN(3)) {
        const float* gbg = args.in[I_GBG];
        for (int row = gw; row < MTOK; row += NGW) {
            const int h = lane >> 2;
            const float l0 = LSE[((size_t)0 * MTOK + row) * NHEAD + h], l1 = LSE[((size_t)1 * MTOK + row) * NHEAD + h], l2 = LSE[((size_t)2 * MTOK + row) * NHEAD + h];
            const float mx = fmaxf(l0, fmaxf(l1, l2));
            float w0 = __builtin_amdgcn_exp2f(l0 - mx), w1 = __builtin_amdgcn_exp2f(l1 - mx), w2 = __builtin_amdgcn_exp2f(l2 - mx);
            const float inv = 1.0f / (w0 + w1 + w2); w0 *= inv; w1 *= inv; w2 *= inv;
            float b[32];
#pragma unroll
            for (int j = 0; j < 32; ++j) b[j] = 0.f;
#pragma unroll
            for (int p = 0; p < 3; ++p) { const float wp = p == 0 ? w0 : (p == 1 ? w1 : w2);
                const GAS v4u* op = (const GAS v4u*)((const bf16*)(outb + OUT_OP + (size_t)p * OP_STRIDE) + (size_t)row * BWID + 32 * lane);
#pragma unroll
                for (int j = 0; j < 4; ++j) { const v4u w = op[j];
                    b[8 * j + 0] += wp * bflo(w.x); b[8 * j + 1] += wp * bfhi(w.x); b[8 * j + 2] += wp * bflo(w.y); b[8 * j + 3] += wp * bfhi(w.y);
                    b[8 * j + 4] += wp * bflo(w.z); b[8 * j + 5] += wp * bfhi(w.z); b[8 * j + 6] += wp * bflo(w.w); b[8 * j + 7] += wp * bfhi(w.w); } }
            float sq = 0.f;
#pragma unroll
            for (int j = 0; j < 32; ++j) sq += b[j] * b[j];
            const float rs = 1.0f / sqrtf(wave_sum(sq) * (1.f / BWID) + EPS);
            GAS v4u* dst = (GAS v4u*)(HN + (size_t)row * DM + AWID + 32 * lane);
            const GAS f32x4* gp = (const GAS f32x4*)(gbg + 32 * lane);
#pragma unroll
            for (int j = 0; j < 4; ++j) { const f32x4 ga = gp[2 * j], gc = gp[2 * j + 1]; v4u o;
                o.x = pk2(b[8 * j + 0] * rs * ga.x, b[8 * j + 1] * rs * ga.y); o.y = pk2(b[8 * j + 2] * rs * ga.z, b[8 * j + 3] * rs * ga.w);
                o.z = pk2(b[8 * j + 4] * rs * gc.x, b[8 * j + 5] * rs * gc.y); o.w = pk2(b[8 * j + 6] * rs * gc.z, b[8 * j + 7] * rs * gc.w); dst[j] = o; }
        }
        GRID_BAR();
    }

    if (IN(4)) {
        pg8::Gemm g{HN, Wout_t, MTOK, DM, DM}; pg8::StaticOrder S; S.init(MTOK, DM, G, (int)blockIdx.x);
        pg8::EpiResNorm E{args.in[I_XP], args.in[I_XS], MPROMPT / 256, OUT, DM, H2, args.in[I_NXG], SSQ1};
        pg8::gemm_phase<pg8::EpiResNorm, pg8::StaticOrder, true, true>(lds + RING_OFF, g, S, E);
        GRID_BAR();
    }
    if (IN(6)) {
        pg8::Gemm g{H2, Wxq_t, MTOK, XW, DM}; pg8::StaticOrder S; S.init(MTOK, XW, G, (int)blockIdx.x);
        pg8::EpiBf16S E{QX, XW, QSCALE, SSQ1};
        pg8::gemm_phase<pg8::EpiBf16S, pg8::StaticOrder, true, true>(lds + RING_OFF, g, S, E);
        GRID_BAR();
    }
    if (IN(7)) {
        LAS unsigned char* vbuf = lds + wave * 16384;
        const int c = lane & 31, hi = lane >> 5, q4 = (lane & 15) >> 2;
        const unsigned rdb = (unsigned)(uintptr_t)vbuf + (unsigned)(hi * 1024 + q4 * 256 + 32 * ((lane >> 4) & 1) + 8 * (lane & 3));
        unsigned xq[4];
#pragma unroll
        for (int dd = 0; dd < 4; ++dd) xq[dd] = (unsigned)(64 * (dd ^ q4));
        const int vchunk = 8 * ((lane & 15) ^ (((lane >> 4) & 3) << 2));
        constexpr int NITEM = XHEADS * (MTOK / 32);
        const int ipw = (NITEM + NGW - 1) / NGW; const int it0 = gw * ipw, it1 = (it0 + ipw < NITEM) ? it0 + ipw : NITEM;
        for (int it = it0; it < it1; ++it) {
            const int xh = it / 1024, tbk = it % 1024, R = 32 * tbk;
            const int mrow0 = (R < MPROMPT) ? 0 : 256 + 256 * ((R - MPROMPT) / SEQ_S);
            bf16x8 qf[8], kf[8];
            { const bf16* qp = QX + (size_t)(R + c) * XW + xh * HD + 8 * hi;
#pragma unroll
              for (int ks = 0; ks < 8; ++ks) qf[ks] = *(const GAS bf16x8*)(qp + 16 * ks); }
            asm volatile("" ::: "memory");
            f32x16 o[4];
#pragma unroll
            for (int dd = 0; dd < 4; ++dd)
#pragma unroll
                for (int i = 0; i < 16; ++i) o[dd][i] = 0.f;
            float m = -1e30f, l = 0.f;
            const bf16* kbase = KVX + (size_t)(mrow0 + c) * (2 * XW) + xh * HD + 8 * hi;
            const bf16* vbase = KVX + (size_t)(mrow0 + (lane >> 4)) * (2 * XW) + XW + xh * HD + vchunk;
            v_dma_issue(vbase, (size_t)4 * 2 * XW, vbuf); asm volatile("" ::: "memory"); k_load_issue(kf, kbase); asm volatile("" ::: "memory");
#pragma unroll 1
            for (int kt = 0; kt < 7; ++kt) {
                v_dma_issue(vbase + (size_t)(32 * (kt + 1)) * (2 * XW), (size_t)4 * 2 * XW, vbuf + ((kt + 1) & 1) * 8192); asm volatile("" ::: "memory");
                attn_tile<false, false>(o, m, l, qf, kf, kbase + (size_t)(32 * (kt + 1)) * (2 * XW), rdb + (unsigned)((kt & 1) * 8192), xq, 0.f, lane, 0, true); }
            attn_tile<false, true>(o, m, l, qf, kf, nullptr, rdb + 8192u, xq, 0.f, lane, 0, true);
            attn_store(o, l, OX + (size_t)(R + c) * XW + xh * HD, hi);
        }
        GRID_BAR();
    }
    if (IN(8)) {
        pg8::Gemm g{OX, Wxo_t, MTOK, DM, XW}; pg8::StaticOrder S; S.init(MTOK, DM, G, (int)blockIdx.x);
        pg8::EpiResNorm E{OUT, OUT, 1 << 30, OUT, DM, HN, args.in[I_NFFNG], SSQ2};
        pg8::gemm_phase<pg8::EpiResNorm, pg8::StaticOrder, true, true>(lds + RING_OFF, g, S, E);
        GRID_BAR();
    }
    if (IN(10)) {
        const float* cw = args.in[I_CONVW]; const float* cb = args.in[I_CONVB];
        { pg8::Gemm g{HN, Wup_t, MTOK, 2 * DFF, DM}; pg8::StaticOrder S; S.init(MTOK, 2 * DFF, G, (int)blockIdx.x);
          pg8::EpiConvGate E{GB, SSQ2, cw, cb, EDGE, (LAS float*)(lds + XCH_OFF), DFF};
          pg8::gemm_phase<pg8::EpiConvGate, pg8::StaticOrder, true, true>(lds + RING_OFF, g, S, E); }
        GRID_BAR();
        { constexpr int NC4 = DFF / 4, LDW = 2 * DFF;
          for (int item = blockIdx.x * 512 + tid; item < (MTOK / 256) * 2 * NC4; item += G * 512) {
              const int c4 = item % NC4, pe = item / NC4, pm = pe >> 1, bot = pe & 1, col = 4 * c4, t = 256 * pm + (bot ? 255 : 0);
              const bool has_prev = (t < MPROMPT) ? (t != 0) : ((t & (SEQ_S - 1)) != 0), has_next = (t < MPROMPT) ? (t != MPROMPT - 1) : ((t & (SEQ_S - 1)) != SEQ_S - 1);
              const float* ep = EDGE + (size_t)pm * 4 * LDW;
              const f32x4 z4 = {0.f, 0.f, 0.f, 0.f};
              f32x4 pg, pv, cg4, cv4, ng, nv;
              if (!bot) { const float* pp = ep - LDW;
                  pg = has_prev ? *(const GAS f32x4*)(pp + col) : z4; pv = has_prev ? *(const GAS f32x4*)(pp + DFF + col) : z4;
                  cg4 = *(const GAS f32x4*)(ep + col); cv4 = *(const GAS f32x4*)(ep + DFF + col); ng = *(const GAS f32x4*)(ep + LDW + col); nv = *(const GAS f32x4*)(ep + LDW + DFF + col); }
              else { const float* np_ = ep + 4 * LDW;
                  pg = *(const GAS f32x4*)(ep + 2 * LDW + col); pv = *(const GAS f32x4*)(ep + 2 * LDW + DFF + col); cg4 = *(const GAS f32x4*)(ep + 3 * LDW + col); cv4 = *(const GAS f32x4*)(ep + 3 * LDW + DFF + col);
                  ng = has_next ? *(const GAS f32x4*)(np_ + col) : z4; nv = has_next ? *(const GAS f32x4*)(np_ + DFF + col) : z4; }
              const f32x4 zg = pg * *(const GAS f32x4*)(cw + col) + cg4 * *(const GAS f32x4*)(cw + LDW + col) + ng * *(const GAS f32x4*)(cw + 2 * LDW + col) + *(const GAS f32x4*)(cb + col);
              const f32x4 zv = pv * *(const GAS f32x4*)(cw + DFF + col) + cv4 * *(const GAS f32x4*)(cw + LDW + DFF + col) + nv * *(const GAS f32x4*)(cw + 2 * LDW + DFF + col) + *(const GAS f32x4*)(cb + DFF + col);
              float gg[4];
#pragma unroll
              for (int j = 0; j < 4; ++j) gg[j] = zg[j] * __builtin_amdgcn_rcpf(1.0f + __builtin_amdgcn_exp2f(-LOG2E * zg[j])) * zv[j];
              v2u o; o.x = pk2(gg[0], gg[1]); o.y = pk2(gg[2], gg[3]);
              *(GAS v2u*)(GB + (size_t)t * DFF + col) = o;
          } }
        GRID_BAR();
        { pg8::Gemm g{GB, Wdn_t, MTOK, DM, DFF}; pg8::StaticOrder S; S.init(MTOK, DM, G, (int)blockIdx.x);
          pg8::EpiResNorm E{OUT, OUT, 1 << 30, OUT, DM, nullptr, nullptr, SSQ3};
          pg8::gemm_phase<pg8::EpiResNorm, pg8::StaticOrder, true, true>(lds + RING_OFF, g, S, E); }
        GRID_BAR();
    }
    if (IN(11)) {
        const GAS f32x4* gp = (const GAS f32x4*)args.in[I_FING]; GAS f32x4* op = (GAS f32x4*)OUT;
        const int nth = G * 512;
        for (int i0 = blockIdx.x * 512 + tid; i0 < MTOK * (DM / 4); i0 += 4 * nth) {
            f32x4 v[4];
#pragma unroll
            for (int k = 0; k < 4; ++k) v[k] = op[i0 + k * nth];
#pragma unroll
            for (int k = 0; k < 4; ++k) { const int i = i0 + k * nth; const float rs = __builtin_amdgcn_rsqf(SSQ3[i >> 10] * (1.0f / DM) + EPS); op[i] = v[k] * rs * gp[i & 1023]; }
        }
    }
#undef IN
#undef GRID_BAR
}

extern "C" void kernel_launch(void* const* d_in, const int* in_sizes, int n_in, void* d_out, int out_size, void* d_ws, size_t ws_size, hipStream_t stream) {
    static int grid = 0;
    if (grid == 0) {
        if (n_in != 24 || out_size != MTOK * DM || ws_size < WS_END) { fprintf(stderr, "kernel_launch: unexpected shapes (n_in %d, out %d, ws %zu)\n", n_in, out_size, ws_size); grid = -1; return; }
        int dev = 0, cus = 0, per_cu = 0;
        if (hipGetDevice(&dev) != hipSuccess || hipDeviceGetAttribute(&cus, hipDeviceAttributeMultiprocessorCount, dev) != hipSuccess) { grid = -1; return; }
        if (hipFuncSetAttribute((const void*)fwd_kernel, hipFuncAttributeMaxDynamicSharedMemorySize, LDS_BYTES) != hipSuccess) { fprintf(stderr, "kernel_launch: hipFuncSetAttribute failed\n"); grid = -1; return; }
        if (hipOccupancyMaxActiveBlocksPerMultiprocessor(&per_cu, (const void*)fwd_kernel, NWAVES * 64, LDS_BYTES) != hipSuccess || per_cu < 1) { fprintf(stderr, "kernel_launch: occupancy query reports %d\n", per_cu); }
        (void)hipGetLastError();
        grid = cus;
    }
    if (grid < 0) return;
    if (hipMemsetAsync((char*)d_ws + WS_CTL, 0, CTL_ZERO_BYTES, stream) != hipSuccess) { fprintf(stderr, "kernel_launch: memset failed\n"); return; }
    Args a{};
    for (int i = 0; i < 24; ++i) a.in[i] = (const float*)d_in[i];
    a.out = (float*)d_out; a.ws = (unsigned char*)d_ws; a.ph_lo = 0; a.ph_hi = 12;
    hipLaunchKernelGGL(fwd_kernel, dim3(grid), dim3(NWAVES * 64), LDS_BYTES, stream, a);
    const hipError_t le = hipPeekAtLastError();
    if (le != hipSuccess) fprintf(stderr, "kernel_launch: launch failed: %s\n", hipGetErrorName(le));
}
```
